# Optimizing an MI355X kernel written in HIP

```python
import math
import jax, jax.numpy as jnp
from jax import lax
import numpy as np

D_MODEL = 1024
BATCH = 8
SEQ = 2048
DEPTH = 2

CTX_LEN = 256
GRID_W = 64
D_MIX = D_MODEL
NA_HEAD_DIM = 64
NA_WIDTH = 3 * D_MIX // 8
NA_HEADS = NA_WIDTH // NA_HEAD_DIM
WIN_ROWS = 8
WIN_COLS = 16
MLA_V_DIM = 64
MLA_WIDTH = 3 * D_MIX // 8
MLA_HEADS = MLA_WIDTH // MLA_V_DIM
MLA_NOPE = 64
MLA_ROPE = 32
MLA_QK = MLA_NOPE + MLA_ROPE
Q_LORA = 3 * D_MODEL // 8
KV_LORA = D_MODEL // 4
S5_WIDTH = D_MIX - NA_WIDTH - MLA_WIDTH
S5_GROUP = 16
S5_GROUPS = S5_WIDTH // S5_GROUP
S5_STATE = 64
DT_MIN = 0.001
DT_MAX = 0.1
D_FF = 2816
ROPE_THETA = 10000.0
EPS = 1e-6
Q_BLOCK = 128
N_MOD = 9
NEG_INF = -1e30
IN_SIZES = (NA_WIDTH, NA_WIDTH, NA_WIDTH, Q_LORA, KV_LORA, MLA_ROPE, S5_WIDTH)
IN_COLS = 3 * NA_WIDTH + Q_LORA + KV_LORA + MLA_ROPE + S5_WIDTH

kernel_name = "hybrid_na_mla_s5_prefix_dit"


def rms_norm(x, g):
    x32 = x.astype(jnp.float32)
    y = x32 * lax.rsqrt(jnp.mean(x32 * x32, axis=-1, keepdims=True) + EPS)
    return (y * g.astype(jnp.float32)).astype(x.dtype)


def modulate(x, g, shift, scale):
    return rms_norm(x, g) * (1 + scale) + shift


def swiglu(x, w_gu, w_down):
    gate, up = jnp.split(x @ w_gu, 2, axis=-1)
    return (jax.nn.silu(gate) * up) @ w_down


def split_cols(z):
    parts, off = [], 0
    for s in IN_SIZES:
        parts.append(z[..., off:off + s])
        off += s
    return parts


def attend(q, k, v, scale):
    s = jnp.einsum('bqhd,bkhd->bhqk', q, k).astype(jnp.float32) * scale
    p = jax.nn.softmax(s, axis=-1).astype(v.dtype)
    return jnp.einsum('bhqk,bkhd->bqhd', p, v)


def attend_joint(q, k1, v1, k2, v2, scale):
    s = jnp.concatenate([jnp.einsum('bqhd,bkhd->bhqk', q, k1),
                         jnp.einsum('bqhd,bkhd->bhqk', q, k2)], axis=-1).astype(jnp.float32) * scale
    p = jax.nn.softmax(s, axis=-1).astype(v1.dtype)
    n1 = k1.shape[1]
    return (jnp.einsum('bhqk,bkhd->bqhd', p[..., :n1], v1)
            + jnp.einsum('bhqk,bkhd->bqhd', p[..., n1:], v2))


def blocked_joint_attention(q, k, v, kc, vc, scale):
    B, N, H, d = q.shape
    nb = N // Q_BLOCK
    qb = q.reshape(B, nb, Q_BLOCK, H, d).transpose(1, 0, 2, 3, 4)
    ob = lax.map(lambda qi: attend_joint(qi, k, v, kc, vc, scale), qb)
    return ob.transpose(1, 0, 2, 3, 4).reshape(B, N, H * v.shape[-1])


def rope_2d(x, row, col):
    half = x.shape[-1] // 2
    quarter = half // 2
    inv = ROPE_THETA ** (-jnp.arange(quarter, dtype=jnp.float32) / quarter)

    def rot(y, pos):
        ang = pos[:, None] * inv
        cos = jnp.cos(ang)[:, None, :].astype(y.dtype)
        sin = jnp.sin(ang)[:, None, :].astype(y.dtype)
        y1, y2 = y[..., :quarter], y[..., quarter:]
        return jnp.concatenate([y1 * cos - y2 * sin, y2 * cos + y1 * sin], axis=-1)

    return jnp.concatenate([rot(x[..., :half], row), rot(x[..., half:], col)], axis=-1)


def rope_tail(x, row, col):
    return jnp.concatenate([x[..., :MLA_NOPE], rope_2d(x[..., MLA_NOPE:], row, col)], axis=-1)


def na_attention(q, k, v, kc, vc, rpb):
    B, N, H, hd = q.shape
    rows = N // GRID_W
    kh = min(WIN_ROWS, rows)
    r = jnp.arange(rows)
    row_start = jnp.clip(r - kh // 2, 0, rows - kh)
    key_rows = row_start[:, None] + jnp.arange(kh)[None, :]
    qg = q.reshape(B, rows, GRID_W, H, hd)
    kg = k.reshape(B, rows, GRID_W, H, hd)[:, key_rows].reshape(B, rows, kh * GRID_W, H, hd)
    vg = v.reshape(B, rows, GRID_W, H, hd)[:, key_rows].reshape(B, rows, kh * GRID_W, H, hd)
    cq = jnp.arange(GRID_W)
    col_start = jnp.clip(cq - WIN_COLS // 2, 0, GRID_W - WIN_COLS)
    kcol = jnp.tile(jnp.arange(GRID_W), kh)
    in_win = (kcol[None, :] >= col_start[:, None]) & (kcol[None, :] < col_start[:, None] + WIN_COLS)
    d_row = jnp.repeat(key_rows - r[:, None], GRID_W, axis=1)
    d_col = jnp.clip(kcol[None, :] - cq[:, None], -(WIN_COLS - 1), WIN_COLS - 1)
    bias = rpb[:, d_row[:, None, :] + WIN_ROWS - 1, d_col[None, :, :] + WIN_COLS - 1]
    scale = hd ** -0.5
    s_win = jnp.einsum('brqhd,brkhd->bhrqk', qg, kg).astype(jnp.float32) * scale + bias[None].astype(jnp.float32)
    s_win = jnp.where(in_win[None, None, None], s_win, NEG_INF)
    s_ctx = jnp.einsum('brqhd,bkhd->bhrqk', qg, kc).astype(jnp.float32) * scale
    p = jax.nn.softmax(jnp.concatenate([s_win, s_ctx], axis=-1), axis=-1).astype(v.dtype)
    kw = kh * GRID_W
    out = (jnp.einsum('bhrqk,brkhd->brqhd', p[..., :kw], vg)
           + jnp.einsum('bhrqk,bkhd->brqhd', p[..., kw:], vc))
    return out.reshape(B, N, H * hd)


def mla_queries(cq, g_cq, w_uq, g_q):
    B, N, _ = cq.shape
    q = (rms_norm(cq, g_cq) @ w_uq).reshape(B, N, MLA_HEADS, MLA_QK)
    return rms_norm(q, g_q)


def mla_keys_values(ckv, kr, g_ckv, w_ukv, g_k):
    B, N, _ = ckv.shape
    kv = (rms_norm(ckv, g_ckv) @ w_ukv).reshape(B, N, MLA_HEADS, MLA_NOPE + MLA_V_DIM)
    k_nope, v = kv[..., :MLA_NOPE], kv[..., MLA_NOPE:]
    k_rope = jnp.broadcast_to(kr[:, :, None, :], (B, N, MLA_HEADS, MLA_ROPE))
    k = rms_norm(jnp.concatenate([k_nope, k_rope], axis=-1), g_k)
    return k, v


def s5_discretize(lam_re, lam_im, log_dt, b_re, b_im):
    lam = lam_re.astype(jnp.float32) + 1j * lam_im.astype(jnp.float32)
    dt = jnp.exp(log_dt.astype(jnp.float32))[:, None]
    lam_bar = jnp.exp(lam * dt)
    b = b_re.astype(jnp.float32) + 1j * b_im.astype(jnp.float32)
    b_bar = ((lam_bar - 1) / lam)[..., None] * b
    return lam_bar, b_bar


def _scan_op(e1, e2):
    a1, b1 = e1
    a2, b2 = e2
    return a1 * a2, a2 * b1 + b2


def linear_scan(lam_bar, bu, h0, reverse):
    if h0 is not None:
        first = -1 if reverse else 0
        bu = bu.at[:, first].add(lam_bar * h0)
    a = jnp.broadcast_to(lam_bar, bu.shape)
    _, h = lax.associative_scan(_scan_op, (a, bu), axis=1, reverse=reverse)
    return h


def s5_mixer(ux, uc, need_ctx_out, lam_re, lam_im, log_dt, b_re, b_im, c_re, c_im, d_skip, w_glu, b_glu):
    B, N, _ = ux.shape
    L = uc.shape[1]
    uxg = ux.reshape(B, N, S5_GROUPS, S5_GROUP).astype(jnp.complex64)
    ucg = uc.reshape(B, L, S5_GROUPS, S5_GROUP).astype(jnp.complex64)
    ys_x, ys_c = [], []
    for d in range(2):
        reverse = d == 1
        lam_bar, b_bar = s5_discretize(lam_re[d], lam_im[d], log_dt[d], b_re[d], b_im[d])
        c_mat = c_re[d].astype(jnp.float32) + 1j * c_im[d].astype(jnp.float32)
        h_c = linear_scan(lam_bar, jnp.einsum('blgm,gpm->blgp', ucg, b_bar), None, reverse)
        h_last = h_c[:, 0] if reverse else h_c[:, -1]
        h_x = linear_scan(lam_bar, jnp.einsum('bngm,gpm->bngp', uxg, b_bar), h_last, reverse)
        ys_x.append(jnp.einsum('bngp,gmp->bngm', h_x, c_mat).real)
        if need_ctx_out:
            ys_c.append(jnp.einsum('blgp,gmp->blgm', h_c, c_mat).real)

    def readout(ys, u):
        y = (ys[0] + ys[1]).reshape(u.shape).astype(u.dtype) + d_skip * u
        a, g = jnp.split(jax.nn.gelu(y) @ w_glu + b_glu, 2, axis=-1)
        return a * jax.nn.sigmoid(g)

    ox = readout(ys_x, ux)
    oc = readout(ys_c, uc) if need_ctx_out else None
    return ox, oc


def token_mixers(zx, zc, need_ctx_out, row, col, na_qk_g, na_rpb, mla_cq_g, mla_ckv_g, mla_w_uq,
                 mla_w_ukv, mla_qk_g, s5_lam_re, s5_lam_im, s5_log_dt, s5_b_re, s5_b_im, s5_c_re,
                 s5_c_im, s5_d, s5_w_glu, s5_b_glu):
    B, N, _ = zx.shape
    L = zc.shape[1]
    qa_x, ka_x, va_x, cq_x, ckv_x, kr_x, u_x = split_cols(zx)
    qa_c, ka_c, va_c, cq_c, ckv_c, kr_c, u_c = split_cols(zc)

    def heads(t):
        return t.reshape(t.shape[0], t.shape[1], NA_HEADS, NA_HEAD_DIM)

    ka_ch = rms_norm(heads(ka_c), na_qk_g[1])
    va_ch = heads(va_c)
    a_x = na_attention(rms_norm(heads(qa_x), na_qk_g[0]), rms_norm(heads(ka_x), na_qk_g[1]),
                       heads(va_x), ka_ch, va_ch, na_rpb)
    kb_c, vb_c = mla_keys_values(ckv_c, kr_c, mla_ckv_g, mla_w_ukv, mla_qk_g[1])
    kb_x, vb_x = mla_keys_values(ckv_x, kr_x, mla_ckv_g, mla_w_ukv, mla_qk_g[1])
    qb_x = rope_tail(mla_queries(cq_x, mla_cq_g, mla_w_uq, mla_qk_g[0]), row, col)
    kb_x = rope_tail(kb_x, row, col)
    b_x = blocked_joint_attention(qb_x, kb_x, vb_x, kb_c, vb_c, MLA_QK ** -0.5)
    s_x, s_c = s5_mixer(u_x, u_c, need_ctx_out, s5_lam_re, s5_lam_im, s5_log_dt, s5_b_re, s5_b_im,
                        s5_c_re, s5_c_im, s5_d, s5_w_glu, s5_b_glu)
    ox = jnp.concatenate([a_x, b_x, s_x], axis=-1)
    if not need_ctx_out:
        return ox, None
    a_c = attend(rms_norm(heads(qa_c), na_qk_g[0]), ka_ch, va_ch, NA_HEAD_DIM ** -0.5).reshape(B, L, NA_WIDTH)
    qb_c = mla_queries(cq_c, mla_cq_g, mla_w_uq, mla_qk_g[0])
    b_c = attend(qb_c, kb_c, vb_c, MLA_QK ** -0.5).reshape(B, L, MLA_WIDTH)
    oc = jnp.concatenate([a_c, b_c, s_c], axis=-1)
    return ox, oc


def setup_inputs(seed: int = 0) -> dict:
    key = jax.random.key(seed)
    keys = jax.random.split(key, 32)
    ctr = [0]
    f32 = jnp.float32

    def nk():
        ctr[0] += 1
        return keys[ctr[0] - 1]

    def nrm(shape, std):
        return std * jax.random.normal(nk(), shape, f32)

    def gain(shape):
        return 1.0 + 0.02 * jax.random.normal(nk(), shape, f32)

    G, P, M = S5_GROUPS, S5_STATE, S5_GROUP
    lam_im_base = jnp.broadcast_to(math.pi * jnp.arange(P, dtype=f32), (DEPTH, 2, G, P))
    return {
        "x": nrm((BATCH, SEQ, D_MODEL), 1.0),
        "c": nrm((BATCH, D_MODEL), 1.0),
        "ctx": nrm((BATCH, CTX_LEN, D_MODEL), 1.0),
        "c_ctx": nrm((D_MODEL,), 1.0),
        "w_mod": nrm((DEPTH, D_MODEL, N_MOD * D_MODEL), 0.2 * D_MODEL ** -0.5),
        "b_mod": nrm((DEPTH, N_MOD * D_MODEL), 0.02),
        "norm_g": gain((DEPTH, 3, D_MODEL)),
        "ffn_w_gu": nrm((DEPTH, 2, D_MODEL, 2 * D_FF), D_MODEL ** -0.5),
        "ffn_w_down": nrm((DEPTH, 2, D_FF, D_MODEL), D_FF ** -0.5),
        "w_in": nrm((DEPTH, D_MODEL, IN_COLS), D_MODEL ** -0.5),
        "w_out": nrm((DEPTH, D_MIX, D_MODEL), D_MIX ** -0.5),
        "na_qk_g": gain((DEPTH, 2, NA_HEAD_DIM)),
        "na_rpb": nrm((DEPTH, NA_HEADS, 2 * WIN_ROWS - 1, 2 * WIN_COLS - 1), 0.02),
        "mla_cq_g": gain((DEPTH, Q_LORA)),
        "mla_ckv_g": gain((DEPTH, KV_LORA)),
        "mla_w_uq": nrm((DEPTH, Q_LORA, MLA_HEADS * MLA_QK), Q_LORA ** -0.5),
        "mla_w_ukv": nrm((DEPTH, KV_LORA, MLA_HEADS * (MLA_NOPE + MLA_V_DIM)), KV_LORA ** -0.5),
        "mla_qk_g": gain((DEPTH, 2, MLA_QK)),
        "s5_lam_re": -0.5 + nrm((DEPTH, 2, G, P), 0.01),
        "s5_lam_im": lam_im_base + nrm((DEPTH, 2, G, P), 0.01),
        "s5_log_dt": jax.random.uniform(nk(), (DEPTH, 2, G), f32, math.log(DT_MIN), math.log(DT_MAX)),
        "s5_b_re": nrm((DEPTH, 2, G, P, M), (2 * M) ** -0.5),
        "s5_b_im": nrm((DEPTH, 2, G, P, M), (2 * M) ** -0.5),
        "s5_c_re": nrm((DEPTH, 2, G, M, P), P ** -0.5),
        "s5_c_im": nrm((DEPTH, 2, G, M, P), P ** -0.5),
        "s5_d": nrm((DEPTH, S5_WIDTH), 1.0),
        "s5_w_glu": nrm((DEPTH, S5_WIDTH, 2 * S5_WIDTH), S5_WIDTH ** -0.5),
        "s5_b_glu": nrm((DEPTH, 2 * S5_WIDTH), 0.02),
    }


def reference(x, c, ctx, c_ctx, w_mod, b_mod, norm_g, ffn_w_gu, ffn_w_down, w_in, w_out, na_qk_g, na_rpb,
              mla_cq_g, mla_ckv_g, mla_w_uq, mla_w_ukv, mla_qk_g, s5_lam_re, s5_lam_im, s5_log_dt,
              s5_b_re, s5_b_im, s5_c_re, s5_c_im, s5_d, s5_w_glu, s5_b_glu):
    B, N, _ = x.shape
    t = jnp.arange(N)
    row = (t // GRID_W).astype(jnp.float32)
    col = (t % GRID_W).astype(jnp.float32)
    hx, hc = x, ctx
    for l in range(DEPTH):
        need_ctx_out = l < DEPTH - 1
        mx = (jax.nn.silu(c) @ w_mod[l] + b_mod[l]).reshape(B, N_MOD, 1, D_MODEL)
        mc = (jax.nn.silu(c_ctx) @ w_mod[l] + b_mod[l]).reshape(N_MOD, D_MODEL)
        hx = hx + 0.5 * mx[:, 2] * swiglu(modulate(hx, norm_g[l, 0], mx[:, 0], mx[:, 1]), ffn_w_gu[l, 0], ffn_w_down[l, 0])
        hc = hc + 0.5 * mc[2] * swiglu(modulate(hc, norm_g[l, 0], mc[0], mc[1]), ffn_w_gu[l, 0], ffn_w_down[l, 0])
        zx = modulate(hx, norm_g[l, 1], mx[:, 3], mx[:, 4]) @ w_in[l]
        zc = modulate(hc, norm_g[l, 1], mc[3], mc[4]) @ w_in[l]
        ox, oc = token_mixers(zx, zc, need_ctx_out, row, col, na_qk_g[l], na_rpb[l], mla_cq_g[l],
                              mla_ckv_g[l], mla_w_uq[l], mla_w_ukv[l], mla_qk_g[l], s5_lam_re[l],
                              s5_lam_im[l], s5_log_dt[l], s5_b_re[l], s5_b_im[l], s5_c_re[l], s5_c_im[l],
                              s5_d[l], s5_w_glu[l], s5_b_glu[l])
        hx = hx + mx[:, 5] * (ox @ w_out[l])
        hx = hx + 0.5 * mx[:, 8] * swiglu(modulate(hx, norm_g[l, 2], mx[:, 6], mx[:, 7]), ffn_w_gu[l, 1], ffn_w_down[l, 1])
        if need_ctx_out:
            hc = hc + mc[5] * (oc @ w_out[l])
            hc = hc + 0.5 * mc[8] * swiglu(modulate(hc, norm_g[l, 2], mc[6], mc[7]), ffn_w_gu[l, 1], ffn_w_down[l, 1])
    return hx
```

```cpp
#include <hip/hip_runtime.h>
#include <hip/hip_cooperative_groups.h>
#include <cstdio>
namespace cg = cooperative_groups;

#define LAS __attribute__((address_space(3)))
#define DI __device__ __forceinline__
typedef unsigned short bf16_t;
typedef short bf16x8 __attribute__((ext_vector_type(8)));
typedef short s16x4 __attribute__((ext_vector_type(4)));
typedef float f32x2 __attribute__((ext_vector_type(2)));
typedef float f32x4 __attribute__((ext_vector_type(4)));
typedef float f32x16 __attribute__((ext_vector_type(16)));
typedef unsigned u32x2 __attribute__((ext_vector_type(2)));
typedef unsigned u32x4 __attribute__((ext_vector_type(4)));
typedef __bf16 bf2_t __attribute__((ext_vector_type(2)));

constexpr int DM = 1024, NB = 8, SEQ = 2048, CTXL = 256;
constexpr int TX = NB * SEQ, TC = NB * CTXL, TT = TX + TC;
constexpr int DFF = 2816, NZ = 1792;
constexpr int ZQA = 0, ZKA = 384, ZCQ = 768, ZCKV = 1152, ZKR = 1408, ZU = 1440;
constexpr float EPSN = 1e-6f, LOG2E = 1.4426950408889634f;
constexpr int NCH = 36;

constexpr size_t SZ_WGU = (size_t)4 * 5632 * 1024 * 2, SZ_WDN = (size_t)4 * 1024 * 2816 * 2, SZ_WIN = (size_t)2 * NZ * 1024 * 2;
constexpr size_t SZ_WVA = (size_t)2 * 512 * 1024 * 2, SZ_WOUT = (size_t)2 * 1024 * 1024 * 2, SZ_WUQ = (size_t)2 * 768 * 384 * 2;
constexpr size_t SZ_WUK = (size_t)2 * 512 * 256 * 2, SZ_WUV = SZ_WUK, SZ_WGLU = SZ_WUK;
constexpr size_t OFF_BAR = 0;
constexpr size_t OFF_CTR = 16384;
constexpr size_t OFF_WGU = 20480;
constexpr size_t OFF_WDN = OFF_WGU + SZ_WGU;
constexpr size_t OFF_WIN = OFF_WDN + SZ_WDN;
constexpr size_t OFF_WVA = OFF_WIN + SZ_WIN;
constexpr size_t OFF_WOUT = OFF_WVA + SZ_WVA;
constexpr size_t OFF_WUQ = OFF_WOUT + SZ_WOUT;
constexpr size_t OFF_WUK = OFF_WUQ + SZ_WUQ;
constexpr size_t OFF_WUV = OFF_WUK + SZ_WUK;
constexpr size_t OFF_WGLU = OFF_WUV + SZ_WUV;
constexpr size_t OFF_MODS = OFF_WGLU + SZ_WGLU;
constexpr size_t OFF_ROPE = OFF_MODS + 663552;
constexpr size_t OFF_S5LAM = OFF_ROPE + 4096;
constexpr size_t OFF_S5BB = OFF_S5LAM + 65536;
constexpr size_t OFF_S5CA = OFF_S5BB + 524288;
constexpr size_t OFF_HXC = OFF_S5CA + 262144;
constexpr size_t OFF_A = OFF_HXC + (size_t)TC * DM * 4;
constexpr size_t OFF_OX = OFF_A + (size_t)TT * DM * 2;
constexpr size_t OFF_H = OFF_OX + (size_t)TT * DM * 2;
constexpr size_t OFF_Z = OFF_H;
constexpr size_t OFF_QM = OFF_Z + (size_t)TT * NZ * 2;
constexpr size_t OFF_VTA = OFF_QM + (size_t)TT * 576 * 2;
constexpr size_t OFF_KM = OFF_H + (size_t)TT * DFF * 2;
constexpr size_t OFF_VTM = OFF_KM + (size_t)TT * 576 * 2;
constexpr size_t OFF_YB = OFF_VTM + (size_t)384 * TT * 2;
constexpr size_t OFF_S5K = OFF_YB + (size_t)TT * 256 * 2;
constexpr size_t OFF_S5E = OFF_S5K + (size_t)64 * 65536 * 2;
constexpr size_t OFF_S5F = OFF_S5E + (size_t)64 * 32768 * 2;
constexpr size_t OFF_S5L16 = OFF_S5F + (size_t)64 * 32768 * 2;
constexpr size_t WS_END = OFF_S5L16 + (size_t)64 * 64 * 8;
static_assert((size_t)4 * TC * DM * 4 <= (size_t)TT * DM * 2, "slab alias overflow");
static_assert(WS_END <= (size_t)352 * 1024 * 1024, "workspace above the guaranteed 4 x largest tensor");
constexpr size_t OFF_SE = OFF_OX;
constexpr size_t OFF_SH = OFF_OX + (size_t)8 * 16 * 2 * 144 * 128 * 4;
static_assert((size_t)8 * 16 * 2 * 144 * 128 * 6 <= (size_t)TT * DM * 2, "S5 alias overflow");
static_assert(OFF_VTA + (size_t)384 * TT * 2 <= OFF_KM, "alias overflow");

struct Params { const float* in[28]; float* out; unsigned char* ws; };

DI unsigned char* ows(const Params& P) { unsigned zero = 0; asm volatile("" : "+s"(zero)); return P.ws + zero; }
DI unsigned pk2(float a, float b) { f32x2 v; v.x = a; v.y = b; return __builtin_bit_cast(unsigned, __builtin_convertvector(v, bf2_t)); }
DI float bflo(unsigned w) { return __uint_as_float(w << 16); }
DI float bfhi(unsigned w) { return __uint_as_float(w & 0xffff0000u); }
DI void unpack8(const u32x4 w, float (&f)[8]) { f[0] = bflo(w.x); f[1] = bfhi(w.x); f[2] = bflo(w.y); f[3] = bfhi(w.y); f[4] = bflo(w.z); f[5] = bfhi(w.z); f[6] = bflo(w.w); f[7] = bfhi(w.w); }
DI u32x4 pack8(const float (&f)[8]) { u32x4 w; w.x = pk2(f[0], f[1]); w.y = pk2(f[2], f[3]); w.z = pk2(f[4], f[5]); w.w = pk2(f[6], f[7]); return w; }
DI float shx(float v, int o, int lane) { return __int_as_float(__builtin_amdgcn_ds_bpermute((lane ^ o) << 2, __float_as_int(v))); }
DI float wave_sum(float v, int lane) {
#pragma unroll
    for (int o = 1; o < 64; o <<= 1) v += shx(v, o, lane);
    return v;
}
DI float fast_exp2(float x) { return __builtin_amdgcn_exp2f(x); }
DI float fast_rcp(float x) { return __builtin_amdgcn_rcpf(x); }
DI float silu_f(float x) { return x * fast_rcp(1.f + fast_exp2(-x * LOG2E)); }
DI float sigmoid_f(float x) { return fast_rcp(1.f + fast_exp2(-x * LOG2E)); }
DI float gelu_tanh_f(float y) { const float t = 0.7978845608028654f * (y + 0.044715f * y * y * y); const float e = fast_exp2(2.f * LOG2E * t); const float th = 1.f - 2.f * fast_rcp(e + 1.f); return 0.5f * y * (1.f + th); }
#define LDS_WAIT() asm volatile("s_waitcnt lgkmcnt(0)" ::: "memory")
DI int otid() { int t = threadIdx.x; asm volatile("" : "+v"(t)); return t; }
DI int oidx(int i) { asm volatile("" : "+s"(i)); return i; }
DI int obid() { int b = blockIdx.x; asm volatile("" : "+s"(b)); return b; }

#define XB_TMO      128
#define XB_XCNT(j)  (256  + 64 * (j))
#define XB_XSUB(j)  (1280 + 64 * (j))
#define XB_XGEN(j)  (2304 + 64 * (j))
#define XB_TOP      3328
#define XB_TOPGEN   3392
#define XCD_BAR_WORDS 3456
#define XB_SPIN_CAP (1u << 20)
DI unsigned xb_ld(unsigned* p) { return __hip_atomic_load(p, __ATOMIC_RELAXED, __HIP_MEMORY_SCOPE_AGENT); }
DI unsigned xb_add(unsigned* p, unsigned v) { return __hip_atomic_fetch_add(p, v, __ATOMIC_RELAXED, __HIP_MEMORY_SCOPE_AGENT); }
DI unsigned xb_xcc_id() { return (unsigned)__builtin_amdgcn_s_getreg((3 << 11) | 20) & 0xFu; }
#define XB_SPIN(cond, bar) do { unsigned _sp = 0; while (cond) { __builtin_amdgcn_s_sleep(1); \
    if ((++_sp & 255u) == 0u) { if (xb_ld(&(bar)[XB_TMO])) break; if (_sp > XB_SPIN_CAP) { atomicAdd(&(bar)[XB_TMO], 1u); break; } } } } while (0)
struct XcdBarrier { unsigned* bar; unsigned x; volatile LAS unsigned* st; };
DI XcdBarrier xcd_barrier_post(unsigned* bar, volatile LAS unsigned* st) {
    XcdBarrier b; b.bar = bar; b.x = xb_xcc_id(); b.st = st;
    if (threadIdx.x == 0) (void)xb_add(&bar[XB_XCNT(b.x)], 1u);
    return b;
}
DI void xcd_barrier_complete(unsigned* bar, unsigned x, unsigned& nloc, unsigned& nx) {
    const unsigned G = gridDim.x * gridDim.y * gridDim.z;
    unsigned sum, cnt, mine, sp = 0u;
    for (;;) {
        sum = 0u; cnt = 0u; mine = 0u;
#pragma unroll
        for (unsigned j = 0; j < 16; ++j) { const unsigned c = xb_ld(&bar[XB_XCNT(j)]); sum += c; cnt += (c > 0u) ? 1u : 0u; mine = (j == x) ? c : mine; }
        if (sum == G) break;
        __builtin_amdgcn_s_sleep(1);
        if ((++sp & 255u) == 0u) { if (xb_ld(&bar[XB_TMO])) break; if (sp > XB_SPIN_CAP) { atomicAdd(&bar[XB_TMO], 1u); break; } }
    }
    nloc = mine > 0u ? mine : 1u; nx = cnt > 0u ? cnt : 1u;
}
DI void xcd_barrier(const XcdBarrier& b) {
    asm volatile("s_waitcnt vmcnt(0)" ::: "memory");
    __syncthreads();
    if (threadIdx.x == 0) {
        const unsigned long long ba = (unsigned long long)b.bar;
        unsigned blo = (unsigned)__builtin_amdgcn_readfirstlane((int)(unsigned)ba), bhi = (unsigned)__builtin_amdgcn_readfirstlane((int)(unsigned)(ba >> 32));
        asm volatile("" : "+s"(blo), "+s"(bhi));
        unsigned* bar = (unsigned*)(((unsigned long long)bhi << 32) | blo);
        const unsigned bx = (unsigned)__builtin_amdgcn_readfirstlane((int)b.x);
        __builtin_amdgcn_s_waitcnt(0);
        unsigned nloc = b.st[0], nx = b.st[1];
        if (nloc == 0u) { xcd_barrier_complete(bar, bx, nloc, nx); b.st[0] = nloc; b.st[1] = nx; }
        const unsigned old = xb_add(&bar[XB_XSUB(bx)], 1u);
        const unsigned gen = old / nloc;
        if (old + 1u == (gen + 1u) * nloc) {
            __builtin_amdgcn_fence(__ATOMIC_RELEASE, "agent");
            asm volatile("s_waitcnt vmcnt(0)" ::: "memory");
            const unsigned og = xb_add(&bar[XB_TOP], 1u);
            const unsigned tg = og / nx;
            if (og + 1u == (tg + 1u) * nx) xb_add(&bar[XB_TOPGEN], 1u);
            else XB_SPIN(xb_ld(&bar[XB_TOPGEN]) == tg, bar);
            __builtin_amdgcn_fence(__ATOMIC_ACQUIRE, "agent");
            xb_add(&bar[XB_XGEN(bx)], 1u);
            asm volatile("s_waitcnt vmcnt(0)" ::: "memory");
        } else {
            XB_SPIN(xb_ld(&bar[XB_XGEN(bx)]) == gen, bar);
            __builtin_amdgcn_fence(__ATOMIC_ACQUIRE, "agent");
            asm volatile("s_waitcnt vmcnt(0)" ::: "memory");
        }
    }
    __syncthreads();
}

namespace pg8 {
constexpr int BM = 256, BK = 64, HALF = 128, HTB = HALF * BK * 2, STAGE_BYTES = 8 * HTB, NXCD = 8, WGM = 8;
DI int lds_byte(int r, int c) { const int st = (r >> 4) * 2 + (c >> 5), rr = r & 15, cc = c & 31, ob = rr * 64 + cc * 2; return st * 1024 + (ob ^ (((ob >> 9) & 1) << 5)); }
DI void stage_rc(int b, int& R, int& C) { const int st = b / 1024, sb = b % 1024, swz = sb ^ (((sb >> 9) & 1) << 5); R = (st >> 1) * 16 + swz / 64; C = (st & 1) * 32 + (swz % 64) / 2; }
DI int perm32(int rho) { const int n = rho >> 4, i = rho & 15; return 8 * (i >> 2) + 4 * n + (i & 3); }
struct Unit { int pm, pn; };
struct Gemm { const bf16_t* A; const bf16_t* Bt; int lda, ldb; int M, N, K; };
struct StaticOrder {
    int nM, nN, nwg, G, c;
    DI void init(int M, int N, int G_, int c_) { nM = M / BM; nN = N / BM; nwg = nM * nN; G = G_; c = c_; }
    DI bool next(int i, Unit& u) const {
        const long L = (long)i * G + c; if (L >= nwg) return false;
        int wgid = (int)L; { const int q = nwg / NXCD, r = nwg % NXCD, xcd = wgid % NXCD, off = wgid / NXCD; wgid = (xcd < r ? xcd * (q + 1) : r * (q + 1) + (xcd - r) * q) + off; }
        const int nig = WGM * nN, gid = wgid / nig, fm = gid * WGM, gsz = (nM - fm) < WGM ? (nM - fm) : WGM;
        u.pm = fm + ((wgid % nig) % gsz); u.pn = (wgid % nig) / gsz; return true;
    }
};

template <class Epi>
DI void gemm_phase(LAS unsigned char* lds, const Gemm g, const StaticOrder& S, const Epi& E) {
    const int tid = otid(), wid = __builtin_amdgcn_readfirstlane(tid >> 6), lane = tid & 63, wr = wid >> 2, wc = wid & 3, fr = lane & 15, fq = lane >> 4;
    const int K = g.K, nt = K / BK;
    unsigned voffA[2], voffB[2];
#pragma unroll
    for (int i = 0; i < 2; ++i) { int R, C; stage_rc(tid * 16 + i * 8192, R, C); const int Rb = Epi::PERM ? ((R & ~31) + perm32(R & 31)) : R;
        voffA[i] = (unsigned)(R * g.lda + C) * 2u; voffB[i] = (unsigned)(Rb * g.ldb + C) * 2u; }
    const size_t kstep = (size_t)(BK * 2);
    const size_t hstepA = (size_t)HALF * g.lda * 2, hstepB = (size_t)HALF * g.ldb * 2;
    const size_t tstepA = 2 * hstepA, tstepB = 2 * hstepB;
    const unsigned ldsw = (unsigned)wid * 1024u;
    const int aoff = lds_byte(wr * 64 + fr, fq * 8), boff = lds_byte(wc * 32 + fr, fq * 8);
#define PG8_SA(b, h) (((b) * 2 + (h)) * HTB)
#define PG8_SB(b, h) ((4 + (b) * 2 + (h)) * HTB)
#define PG8_STAGE(bufoff, gbase, voff) do { _Pragma("unroll") for (int _i = 0; _i < 2; ++_i) \
        __builtin_amdgcn_global_load_lds((const unsigned*)((const char*)(gbase) + (voff)[_i]), (LAS unsigned*)(lds + (bufoff) + ldsw + _i * 8192), 16, 0, 0); } while (0)
#define PG8_LDA(dst, b, h) do { _Pragma("unroll") for (int m = 0; m < 4; ++m) _Pragma("unroll") for (int k = 0; k < 2; ++k) dst[m][k] = *(const LAS bf16x8*)(lds + PG8_SA(b, h) + aoff + m * 2048 + k * 1024); } while (0)
#define PG8_LDB(dst, b, h) do { _Pragma("unroll") for (int n = 0; n < 2; ++n) _Pragma("unroll") for (int k = 0; k < 2; ++k) dst[n][k] = *(const LAS bf16x8*)(lds + PG8_SB(b, h) + boff + n * 2048 + k * 1024); } while (0)
#define PG8_MMA(ai, bj, At, Bt) do { __builtin_amdgcn_s_setprio(1); _Pragma("unroll") for (int m = 0; m < 4; ++m) _Pragma("unroll") for (int n = 0; n < 2; ++n) _Pragma("unroll") for (int k = 0; k < 2; ++k) \
        acc[ai][bj][m][n] = __builtin_amdgcn_mfma_f32_16x16x32_bf16(Bt[n][k], At[m][k], acc[ai][bj][m][n], 0, 0, 0); __builtin_amdgcn_s_setprio(0); } while (0)
#define PG8_WAIT_V(n) asm volatile("s_waitcnt vmcnt(" #n ")" ::: "memory")
#define PG8_WAIT_L(n) asm volatile("s_waitcnt lgkmcnt(" #n ")" ::: "memory")
#define PG8_BAR __builtin_amdgcn_s_barrier()
#define PG8_SCHED __builtin_amdgcn_sched_barrier(0)
    Unit cur, nxt; int ui = 0;
    if (!S.next(0, cur)) return;
    f32x4 acc[2][2][4][2];
#pragma unroll
    for (int a = 0; a < 2; ++a)
#pragma unroll
        for (int b = 0; b < 2; ++b)
#pragma unroll
            for (int m = 0; m < 4; ++m)
#pragma unroll
                for (int n = 0; n < 2; ++n) acc[a][b][m][n] = (f32x4){0.f, 0.f, 0.f, 0.f};
    bf16x8 At[4][2], B0[2][2], B1[2][2];
    const char* cA = (const char*)g.A + (size_t)cur.pm * tstepA; const char* cB = (const char*)g.Bt + (size_t)cur.pn * tstepB;
    PG8_STAGE(PG8_SB(0, 0), cB, voffB); PG8_STAGE(PG8_SA(0, 0), cA, voffA); PG8_STAGE(PG8_SB(0, 1), cB + hstepB, voffB); PG8_STAGE(PG8_SA(0, 1), cA + hstepA, voffA);
    if (wr == 1) PG8_BAR;
    PG8_WAIT_V(4); PG8_BAR;
    PG8_STAGE(PG8_SB(1, 0), cB + kstep, voffB); PG8_STAGE(PG8_SA(1, 0), cA + kstep, voffA); PG8_STAGE(PG8_SB(1, 1), cB + hstepB + kstep, voffB);
    PG8_WAIT_V(6); PG8_BAR;
    for (;;) {
        const bool has_next = S.next(ui + 1, nxt);
        const char* nA = has_next ? (const char*)g.A + (size_t)nxt.pm * tstepA : cA; const char* nB = has_next ? (const char*)g.Bt + (size_t)nxt.pn * tstepB : cB;
        for (int t = 0; t < nt; t += 2) {
            const bool last = (t == nt - 2);
            const char* a1 = cA + (size_t)(t + 1) * kstep;
            const char* a2 = last ? nA : cA + (size_t)(t + 2) * kstep; const char* b2 = last ? nB : cB + (size_t)(t + 2) * kstep;
            const char* a3 = a2 + kstep; const char* b3 = b2 + kstep;
            PG8_LDB(B0, 0, 0); PG8_SCHED; PG8_LDA(At, 0, 0); PG8_STAGE(PG8_SA(1, 1), a1 + hstepA, voffA);
            PG8_WAIT_L(8); PG8_BAR; PG8_WAIT_L(0); PG8_MMA(0, 0, At, B0); PG8_BAR; PG8_SCHED;
            PG8_LDB(B1, 0, 1); PG8_STAGE(PG8_SB(0, 0), b2, voffB);
            PG8_BAR; PG8_WAIT_L(0); PG8_MMA(0, 1, At, B1); PG8_BAR;
            PG8_LDA(At, 0, 1); PG8_STAGE(PG8_SA(0, 0), a2, voffA);
            PG8_BAR; PG8_WAIT_L(0); PG8_MMA(1, 0, At, B0); PG8_BAR; PG8_SCHED;
            PG8_STAGE(PG8_SB(0, 1), b2 + hstepB, voffB);
            PG8_WAIT_V(6); PG8_BAR; PG8_MMA(1, 1, At, B1); PG8_BAR;
            PG8_LDB(B0, 1, 0); PG8_SCHED; PG8_LDA(At, 1, 0); PG8_STAGE(PG8_SA(0, 1), a2 + hstepA, voffA);
            PG8_WAIT_L(8); PG8_BAR; PG8_WAIT_L(0); PG8_MMA(0, 0, At, B0); PG8_BAR; PG8_SCHED;
            PG8_LDB(B1, 1, 1); PG8_STAGE(PG8_SB(1, 0), b3, voffB);
            PG8_BAR; PG8_WAIT_L(0); PG8_MMA(0, 1, At, B1); PG8_BAR;
            PG8_LDA(At, 1, 1); PG8_STAGE(PG8_SA(1, 0), a3, voffA);
            PG8_BAR; PG8_WAIT_L(0); PG8_MMA(1, 0, At, B0); PG8_BAR; PG8_SCHED;
            PG8_STAGE(PG8_SB(1, 1), b3 + hstepB, voffB);
            PG8_WAIT_V(6); PG8_BAR; PG8_MMA(1, 1, At, B1); PG8_BAR;
        }
        E(acc, cur, wr, wc, fr, fq);
        if (!has_next) break;
#pragma unroll
        for (int a = 0; a < 2; ++a)
#pragma unroll
            for (int b = 0; b < 2; ++b)
#pragma unroll
                for (int m = 0; m < 4; ++m)
#pragma unroll
                    for (int n = 0; n < 2; ++n) acc[a][b][m][n] = (f32x4){0.f, 0.f, 0.f, 0.f};
        cur = nxt; cA = nA; cB = nB; ++ui;
    }
    PG8_WAIT_V(0);
    if (wr == 0) PG8_BAR;
    PG8_BAR;
#undef PG8_SA
#undef PG8_SB
#undef PG8_STAGE
#undef PG8_LDA
#undef PG8_LDB
#undef PG8_MMA
#undef PG8_WAIT_V
#undef PG8_WAIT_L
#undef PG8_BAR
#undef PG8_SCHED
}

struct EpiSwiglu {
    static constexpr bool PERM = true;
    bf16_t* H; int ldh;
    DI void operator()(const f32x4 (&acc)[2][2][4][2], const Unit& u, int wr, int wc, int fr, int fq) const {
        const int row0 = u.pm * BM + wr * 64 + fr, col0 = u.pn * HALF + wc * 32 + 8 * fq;
#pragma unroll
        for (int ai = 0; ai < 2; ++ai)
#pragma unroll
            for (int m = 0; m < 4; ++m) {
                bf16_t* rowp = H + (size_t)(row0 + ai * HALF + m * 16) * ldh + col0;
                const f32x4 g0 = acc[ai][0][m][0], g1 = acc[ai][0][m][1], u0 = acc[ai][1][m][0], u1 = acc[ai][1][m][1];
                u32x4 w;
                w.x = pk2(silu_f(g0[0]) * u0[0], silu_f(g0[1]) * u0[1]); w.y = pk2(silu_f(g0[2]) * u0[2], silu_f(g0[3]) * u0[3]);
                w.z = pk2(silu_f(g1[0]) * u1[0], silu_f(g1[1]) * u1[1]); w.w = pk2(silu_f(g1[2]) * u1[2], silu_f(g1[3]) * u1[3]);
                *(u32x4*)rowp = w;
            }
    }
};
struct EpiGlu {
    static constexpr bool PERM = true;
    bf16_t* O; int ldo; int col_base; const float* bias;
    DI void operator()(const f32x4 (&acc)[2][2][4][2], const Unit& u, int wr, int wc, int fr, int fq) const {
        const int row0 = u.pm * BM + wr * 64 + fr, c0 = u.pn * HALF + wc * 32 + 8 * fq;
#pragma unroll
        for (int ai = 0; ai < 2; ++ai)
#pragma unroll
            for (int m = 0; m < 4; ++m) {
                const f32x4 ba0 = *(const volatile f32x4*)(bias + c0), ba1 = *(const volatile f32x4*)(bias + c0 + 4), bg0 = *(const volatile f32x4*)(bias + 256 + c0), bg1 = *(const volatile f32x4*)(bias + 256 + c0 + 4);
                bf16_t* rowp = O + (size_t)(row0 + ai * HALF + m * 16) * ldo + col_base + c0;
                const f32x4 a0 = acc[ai][0][m][0] + ba0, a1 = acc[ai][0][m][1] + ba1, g0 = acc[ai][1][m][0] + bg0, g1 = acc[ai][1][m][1] + bg1;
                u32x4 w;
                w.x = pk2(a0[0] * sigmoid_f(g0[0]), a0[1] * sigmoid_f(g0[1])); w.y = pk2(a0[2] * sigmoid_f(g0[2]), a0[3] * sigmoid_f(g0[3]));
                w.z = pk2(a1[0] * sigmoid_f(g1[0]), a1[1] * sigmoid_f(g1[1])); w.w = pk2(a1[2] * sigmoid_f(g1[2]), a1[3] * sigmoid_f(g1[3]));
                *(u32x4*)rowp = w;
            }
    }
};
struct EpiResid {
    static constexpr bool PERM = false;
    const float* rin_x; const float* rin_c; float* rout_x; float* rout_c; const float* gate; float gs;
    DI void operator()(const f32x4 (&acc)[2][2][4][2], const Unit& u, int wr, int wc, int fr, int fq) const {
        const int trow = u.pm * BM; const bool isx = trow < TX;
        const int mb = isx ? (trow >> 11) : 8;
        const float* rin = isx ? rin_x + (size_t)trow * DM : rin_c + (size_t)(trow - TX) * DM;
        float* rout = isx ? rout_x + (size_t)trow * DM : rout_c + (size_t)(trow - TX) * DM;
        const int r0 = wr * 64 + fr, col0 = u.pn * BM + wc * 32 + 4 * fq;
        f32x4 gv[2][2];
#pragma unroll
        for (int bj = 0; bj < 2; ++bj)
#pragma unroll
            for (int n = 0; n < 2; ++n) gv[bj][n] = *(const f32x4*)(gate + (size_t)mb * 9216 + col0 + bj * HALF + n * 16) * gs;
#pragma unroll
        for (int ai = 0; ai < 2; ++ai)
#pragma unroll
            for (int m = 0; m < 4; ++m) {
                const size_t ro = (size_t)(r0 + ai * HALF + m * 16) * DM + col0;
#pragma unroll
                for (int bj = 0; bj < 2; ++bj)
#pragma unroll
                    for (int n = 0; n < 2; ++n) {
                        const f32x4 r = *(const f32x4*)(rin + ro + bj * HALF + n * 16);
                        *(f32x4*)(rout + ro + bj * HALF + n * 16) = r + gv[bj][n] * acc[ai][bj][m][n];
                    }
            }
    }
};
struct EpiResidAtomicC {
    static constexpr bool PERM = false;
    float* rout_c; const float* gate; float gs;
    DI void operator()(const f32x4 (&acc)[2][2][4][2], const Unit& u, int wr, int wc, int fr, int fq) const {
        float* rout = rout_c + (size_t)u.pm * BM * DM;
        const int r0 = wr * 64 + fr, col0 = u.pn * BM + wc * 32 + 4 * fq;
#pragma unroll
        for (int bj = 0; bj < 2; ++bj)
#pragma unroll
            for (int n = 0; n < 2; ++n) {
                const f32x4 gv = *(const f32x4*)(gate + (size_t)8 * 9216 + col0 + bj * HALF + n * 16) * gs;
#pragma unroll
                for (int ai = 0; ai < 2; ++ai)
#pragma unroll
                    for (int m = 0; m < 4; ++m) *(f32x4*)(rout + (size_t)(r0 + ai * HALF + m * 16) * DM + col0 + bj * HALF + n * 16) = gv * acc[ai][bj][m][n];
            }
    }
};
struct EpiStore {
    static constexpr bool PERM = true;
    bf16_t* O; int ldo; int rows_valid; int cols_valid; int kmap;
    DI void operator()(const f32x4 (&acc)[2][2][4][2], const Unit& u, int wr, int wc, int fr, int fq) const {
        const int row0 = u.pm * BM + wr * 64 + fr;
#pragma unroll
        for (int bj = 0; bj < 2; ++bj) {
            const int c = u.pn * BM + bj * HALF + wc * 32 + 8 * fq;
            if (c >= cols_valid) continue;
            const int cd = kmap ? (96 * (c >> 6) + (c & 63)) : c;
#pragma unroll
            for (int ai = 0; ai < 2; ++ai)
#pragma unroll
                for (int m = 0; m < 4; ++m) {
                    const int row = row0 + ai * HALF + m * 16;
                    if (row < rows_valid) {
                        const f32x4 v0 = acc[ai][bj][m][0], v1 = acc[ai][bj][m][1];
                        u32x4 w; w.x = pk2(v0[0], v0[1]); w.y = pk2(v0[2], v0[3]); w.z = pk2(v1[0], v1[1]); w.w = pk2(v1[2], v1[3]);
                        *(u32x4*)(O + (size_t)row * ldo + cd) = w;
                    }
                }
        }
    }
};
}

template <class Epi>
DI void gemm_call(LAS unsigned char* lds, const bf16_t* A, int lda, const bf16_t* Bt, int ldb, int M, int N, int K, const Epi& E, int coff) {
    pg8::Gemm g; g.A = A; g.Bt = Bt; g.lda = lda; g.ldb = ldb; g.M = M; g.N = N; g.K = K;
    pg8::StaticOrder S; S.init(M, N, (int)gridDim.x, (int)(((unsigned)obid() + (unsigned)coff) % gridDim.x));
    pg8::gemm_phase<Epi>(lds, g, S, E);
}


DI void transpose_item(const float* W, int K, int N, bf16_t* WT, int k0, int n0, int drow0, LAS float* scr, int lane) {
    f32x4 tv[8];
    const int kr = lane >> 3, n4 = (lane & 7) * 4;
#pragma unroll
    for (int i = 0; i < 8; ++i) tv[i] = *(const f32x4*)(W + (size_t)(k0 + 8 * i + kr) * N + n0 + n4);
#pragma unroll
    for (int i = 0; i < 8; ++i) { LAS float* d = scr + (8 * i + kr) * 33 + n4; d[0] = tv[i][0]; d[1] = tv[i][1]; d[2] = tv[i][2]; d[3] = tv[i][3]; }
    LDS_WAIT();
    const int c = lane & 7;
#pragma unroll
    for (int j = 0; j < 4; ++j) {
        const int n = (lane >> 3) + 8 * j; const LAS float* sp = scr + (8 * c) * 33 + n;
        u32x4 o; o.x = pk2(sp[0 * 33], sp[1 * 33]); o.y = pk2(sp[2 * 33], sp[3 * 33]); o.z = pk2(sp[4 * 33], sp[5 * 33]); o.w = pk2(sp[6 * 33], sp[7 * 33]);
        *(u32x4*)(WT + (size_t)(drow0 + n) * K + k0 + 8 * c) = o;
    }
    LDS_WAIT();
}
DI int gu_map(int n0, int half) { const int j = n0 < half ? n0 : n0 - half; return 256 * (j >> 7) + (n0 < half ? 0 : 128) + (j & 127); }
constexpr int I_GU = 2 * 16 * 176, I_DN = 2 * 44 * 32, I_IN = 16 * 65, I_OUT = 16 * 32, I_UQ = 6 * 18, I_UKV = 4 * 24, I_GLU = 4 * 16;
constexpr int I_L = I_GU + I_DN + I_IN + I_OUT + I_UQ + I_UKV + I_GLU;
constexpr int I_FIRST = 16 * 176;
DI void do_transposes(const Params& P, LAS unsigned char* lds, int first, int last, int widx, int nw) {
    const int tid_ = otid(); const int lane = tid_ & 63, wave = tid_ >> 6;
    unsigned char* ws = ows(P);
    LAS float* scr = (LAS float*)lds + wave * (64 * 33);
    for (int it = first + widx; it < last; it += nw) {
        const int l = it / I_L; int r = it % I_L;
        if (r < I_GU) { const int f = r / (16 * 176), q = r % (16 * 176), kb = q / 176, nb = q % 176, n0 = nb * 32;
            transpose_item(P.in[oidx(7)] + (size_t)(l * 2 + f) * 1024 * 5632, 1024, 5632, (bf16_t*)(ws + OFF_WGU) + (size_t)(l * 2 + f) * 5632 * 1024, kb * 64, n0, gu_map(n0, 2816), scr, lane); continue; }
        r -= I_GU;
        if (r < I_DN) { const int f = r / (44 * 32), q = r % (44 * 32), kb = q / 32, nb = q % 32;
            transpose_item(P.in[oidx(8)] + (size_t)(l * 2 + f) * 2816 * 1024, 2816, 1024, (bf16_t*)(ws + OFF_WDN) + (size_t)(l * 2 + f) * 1024 * 2816, kb * 64, nb * 32, nb * 32, scr, lane); continue; }
        r -= I_DN;
        if (r < I_IN) { const int kb = r / 65, nb = r % 65, n0 = nb * 32;
            bf16_t* dst; int drow;
            if (n0 < 768) { dst = (bf16_t*)(ws + OFF_WIN) + (size_t)l * NZ * 1024; drow = n0; }
            else if (n0 < 1152) { dst = (bf16_t*)(ws + OFF_WVA) + (size_t)l * 512 * 1024; drow = n0 - 768; }
            else { dst = (bf16_t*)(ws + OFF_WIN) + (size_t)l * NZ * 1024; drow = n0 - 384; }
            transpose_item(P.in[oidx(9)] + (size_t)l * 1024 * 2080, 1024, 2080, dst, kb * 64, n0, drow, scr, lane); continue; }
        r -= I_IN;
        if (r < I_OUT) { const int kb = r / 32, nb = r % 32;
            transpose_item(P.in[oidx(10)] + (size_t)l * 1024 * 1024, 1024, 1024, (bf16_t*)(ws + OFF_WOUT) + (size_t)l * 1024 * 1024, kb * 64, nb * 32, nb * 32, scr, lane); continue; }
        r -= I_OUT;
        if (r < I_UQ) { const int kb = r / 18, nb = r % 18;
            transpose_item(P.in[oidx(15)] + (size_t)l * 384 * 576, 384, 576, (bf16_t*)(ws + OFF_WUQ) + (size_t)l * 768 * 384, kb * 64, nb * 32, nb * 32, scr, lane); continue; }
        r -= I_UQ;
        if (r < I_UKV) { const int kb = r / 24, nb = r % 24, n0 = nb * 32, h = n0 >> 7, j = n0 & 127;
            bf16_t* dst = (j < 64) ? (bf16_t*)(ws + OFF_WUK) + (size_t)l * 512 * 256 : (bf16_t*)(ws + OFF_WUV) + (size_t)l * 512 * 256;
            transpose_item(P.in[oidx(16)] + (size_t)l * 256 * 768, 256, 768, dst, kb * 64, n0, 64 * h + (j & 63), scr, lane); continue; }
        r -= I_UKV;
        { const int kb = r / 16, nb = r % 16, n0 = nb * 32;
            transpose_item(P.in[oidx(26)] + (size_t)l * 256 * 512, 256, 512, (bf16_t*)(ws + OFF_WGLU) + (size_t)l * 512 * 256, kb * 64, n0, gu_map(n0, 256), scr, lane); }
    }
}

DI void deferred_transposes(const Params& P, LAS unsigned char* lds, int slot, int first_idle) {
    const int c = obid(); if (c < first_idle || slot > 3) return;
    const int nw = (256 - first_idle) * 8, widx = (c - first_idle) * 8 + (otid() >> 6);
    if (slot == 0) { do_transposes(P, lds, 5632, 7040, widx, nw); do_transposes(P, lds, 8448, I_L, widx, nw); }
    else if (slot == 1) { do_transposes(P, lds, 2816, 5632, widx, nw); do_transposes(P, lds, 7040, 8448, widx, nw); }
    else if (slot == 2) { do_transposes(P, lds, I_L + 0, I_L + 2816, widx, nw); do_transposes(P, lds, I_L + 5632, I_L + 7040, widx, nw); do_transposes(P, lds, I_L + 8448, 2 * I_L, widx, nw); }
    else { do_transposes(P, lds, I_L + 2816, I_L + 5632, widx, nw); do_transposes(P, lds, I_L + 7040, I_L + 8448, widx, nw); }
}
DI void s5_tables(const Params& P, int ldg, LAS unsigned char* lds, int tid);
DI void phase_prep(const Params& P, LAS unsigned char* lds) {
    const int tid = otid(), lane = tid & 63, wave = tid >> 6, G = gridDim.x, bid = obid();
    unsigned char* ws = ows(P);
    if (bid == 0 && tid < 64) ((unsigned*)(ws + OFF_CTR))[tid] = 0u;
    {
        LAS float* sv = (LAS float*)lds; LAS float* red = sv + 9 * 1024;
        for (int i = tid; i < 9 * 1024; i += 512) { const int mb = i >> 10, k = i & 1023; const float c = mb < 8 ? P.in[oidx(1)][mb * 1024 + k] : P.in[oidx(3)][k]; sv[i] = c / (1.f + expf(-c)); }
        __syncthreads();
        float* mods = (float*)(ws + OFF_MODS);
        for (int u = bid; u < 288; u += G) {
            const int l = u / 144, cgp = u % 144, kq = lane >> 4, c4 = (lane & 15) * 4;
            const float* W = P.in[oidx(4)] + (size_t)l * 1024 * 9216 + cgp * 64 + c4;
            f32x4 a[9];
#pragma unroll
            for (int mb = 0; mb < 9; ++mb) a[mb] = (f32x4){0.f, 0.f, 0.f, 0.f};
            for (int i0 = 0; i0 < 32; i0 += 8) {
                f32x4 w8[8];
#pragma unroll
                for (int i = 0; i < 8; ++i) w8[i] = *(const f32x4*)(W + (size_t)(wave * 128 + 4 * (i0 + i) + kq) * 9216);
#pragma unroll
                for (int i = 0; i < 8; ++i) { const int k = wave * 128 + 4 * (i0 + i) + kq;
#pragma unroll
                    for (int mb = 0; mb < 9; ++mb) a[mb] += w8[i] * sv[mb * 1024 + k]; }
            }
#pragma unroll
            for (int mb = 0; mb < 9; ++mb) *(LAS f32x4*)(red + ((wave * 4 + kq) * 9 + mb) * 64 + c4) = a[mb];
            __syncthreads();
            for (int i = tid; i < 576; i += 512) {
                const int mb = i >> 6, cc = i & 63; float sum = 0.f;
#pragma unroll
                for (int k32 = 0; k32 < 32; ++k32) sum += red[(k32 * 9 + mb) * 64 + cc];
                mods[(size_t)(l * 9 + mb) * 9216 + cgp * 64 + cc] = sum + P.in[oidx(5)][l * 9216 + cgp * 64 + cc];
            }
            __syncthreads();
        }
        __syncthreads();
    }
    { const f32x4* src = (const f32x4*)P.in[oidx(2)]; f32x4* dst = (f32x4*)(ws + OFF_HXC); for (int i = bid * 512 + tid; i < TC * DM / 4; i += G * 512) dst[i] = src[i]; }
    const int gtid = bid * 512 + tid, GT = G * 512;
    if (gtid < 512) { const int pos = gtid >> 3, i = gtid & 7; const float inv = exp2f(-(float)i * 0.125f * 13.287712379549449f); const float ang = (float)pos * inv;
        float* rt = (float*)(ws + OFF_ROPE); rt[gtid * 2] = cosf(ang); rt[gtid * 2 + 1] = sinf(ang); }
    for (int it = (bid + G - 64) % G; it < 64; it += G) s5_tables(P, it, lds, tid);
    __syncthreads();
    do_transposes(P, lds, 0, gridDim.x == 256 ? I_FIRST : 2 * I_L, bid * 8 + wave, G * 8);
}

DI void phase_modulate(const float* src_x, float* src_c, int nrows, const float* g, const float* shift, const float* scale, bf16_t* A, const float* slab) {
    const int tid_ = otid(); const int lane = tid_ & 63, gw = obid() * 8 + (tid_ >> 6), NGW = gridDim.x * 8;
    for (int row = gw; row < nrows; row += NGW) {
        const float* xr = row < TX ? src_x + (size_t)row * DM : src_c + (size_t)(row - TX) * DM;
        const int mb = row < TX ? (row >> 11) : 8;
        f32x4 v[4]; float ss = 0.f;
#pragma unroll
        for (int j = 0; j < 4; ++j) v[j] = *(const f32x4*)(xr + 4 * lane + 256 * j);
        if (slab != nullptr && row >= TX) {
            const float* s0 = slab + (size_t)(row - TX) * DM; float* hw = src_c + (size_t)(row - TX) * DM;
#pragma unroll
            for (int j = 0; j < 4; ++j) { v[j] += (*(const f32x4*)(s0 + 4 * lane + 256 * j) + *(const f32x4*)(s0 + (size_t)TC * DM + 4 * lane + 256 * j))
                                              + (*(const f32x4*)(s0 + (size_t)2 * TC * DM + 4 * lane + 256 * j) + *(const f32x4*)(s0 + (size_t)3 * TC * DM + 4 * lane + 256 * j)); *(f32x4*)(hw + 4 * lane + 256 * j) = v[j]; }
        }
#pragma unroll
        for (int j = 0; j < 4; ++j) ss += v[j].x * v[j].x + v[j].y * v[j].y + v[j].z * v[j].z + v[j].w * v[j].w;
        const float r = 1.f / sqrtf(wave_sum(ss, lane) * (1.f / DM) + EPSN);
#pragma unroll
        for (int j = 0; j < 4; ++j) {
            const int c = 4 * lane + 256 * j;
            const f32x4 gg = *(const f32x4*)(g + c), sh = *(const f32x4*)(shift + (size_t)mb * 9216 + c), sc = *(const f32x4*)(scale + (size_t)mb * 9216 + c);
            const f32x4 y = v[j] * r * gg * (sc + 1.f) + sh;
            u32x2 w; w.x = pk2(y.x, y.y); w.y = pk2(y.z, y.w);
            *(u32x2*)(A + (size_t)row * DM + c) = w;
        }
    }
}

DI void phase_znorm(const Params& P, int l) {
    const int tid_ = otid(); const int lane = tid_ & 63, gw = obid() * 8 + (tid_ >> 6), NGW = gridDim.x * 8;
    bf16_t* z = (bf16_t*)(ows(P) + OFF_Z);
    const float* gq = P.in[oidx(11)] + l * 128; const float* gk = gq + 64;
    const float* gcq = P.in[oidx(13)] + l * 384; const float* gckv = P.in[oidx(14)] + l * 256;
    const float qs = 0.125f * LOG2E;
    for (int row = gw; row < TT; row += NGW) {
        bf16_t* zr = z + (size_t)row * NZ;
        const bool a48 = lane < 48, a32 = lane < 32;
        u32x4 wq = {0, 0, 0, 0}, wk = {0, 0, 0, 0}, wc = {0, 0, 0, 0}, wv = {0, 0, 0, 0};
        if (a48) { wq = *(const u32x4*)(zr + ZQA + 8 * lane); wk = *(const u32x4*)(zr + ZKA + 8 * lane); wc = *(const u32x4*)(zr + ZCQ + 8 * lane); }
        if (a32) wv = *(const u32x4*)(zr + ZCKV + 8 * lane);
        float fq[8], fk[8], fc[8], fv[8]; unpack8(wq, fq); unpack8(wk, fk); unpack8(wc, fc); unpack8(wv, fv);
        float sq = 0, sk = 0, sc = 0, sv = 0;
#pragma unroll
        for (int i = 0; i < 8; ++i) { sq += fq[i] * fq[i]; sk += fk[i] * fk[i]; sc += fc[i] * fc[i]; sv += fv[i] * fv[i]; }
#pragma unroll
        for (int o = 1; o < 8; o <<= 1) { sq += shx(sq, o, lane); sk += shx(sk, o, lane); }
        sc = wave_sum(sc, lane); sv = wave_sum(sv, lane);
        const float rq = qs / sqrtf(sq * (1.f / 64.f) + EPSN), rk = 1.f / sqrtf(sk * (1.f / 64.f) + EPSN);
        const float rc = 1.f / sqrtf(sc * (1.f / 384.f) + EPSN), rv = 1.f / sqrtf(sv * (1.f / 256.f) + EPSN);
        const int hc = (8 * lane) & 63;
        if (a48) {
#pragma unroll
            for (int i = 0; i < 8; ++i) { fq[i] *= rq * gq[hc + i]; fk[i] *= rk * gk[hc + i]; fc[i] *= rc * gcq[8 * lane + i]; }
            *(u32x4*)(zr + ZQA + 8 * lane) = pack8(fq); *(u32x4*)(zr + ZKA + 8 * lane) = pack8(fk); *(u32x4*)(zr + ZCQ + 8 * lane) = pack8(fc);
        }
        if (a32) {
#pragma unroll
            for (int i = 0; i < 8; ++i) fv[i] *= rv * gckv[8 * lane + i];
            *(u32x4*)(zr + ZCKV + 8 * lane) = pack8(fv);
        }
    }
}

DI void phase_finish(const Params& P, int l) {
    const int tid_ = otid(); const int lane = tid_ & 63, gw = obid() * 8 + (tid_ >> 6), NGW = gridDim.x * 8;
    bf16_t* Qm = (bf16_t*)(ows(P) + OFF_QM); bf16_t* Km = (bf16_t*)(ows(P) + OFF_KM); const bf16_t* z = (const bf16_t*)(ows(P) + OFF_Z);
    const float* gq = P.in[oidx(17)] + l * 192; const float* gk = gq + 96;
    const float* rope = (const float*)(ows(P) + OFF_ROPE);
    const float qs = 0.10206207261596575f * LOG2E;
    const int hq = lane >> 4, ch = lane & 15;
    for (int row = gw; row < TT; row += NGW) {
        const bool lat = row < TX; const int n = row & 2047; const int pos = (ch < 10) ? (n >> 6) : (n & 63);
        const bool doq = lat || l == 0;
#pragma unroll
        for (int pass = 0; pass < 2; ++pass) {
            const int head = 4 * pass + hq; const bool act = (head < 6) && (ch < 12);
            u32x4 wq = {0, 0, 0, 0}, wk = {0, 0, 0, 0};
            if (act) {
                if (doq) wq = *(const u32x4*)(Qm + (size_t)row * 576 + head * 96 + 8 * ch);
                if (ch < 8) wk = *(const u32x4*)(Km + (size_t)row * 576 + head * 96 + 8 * ch);
                else wk = *(const u32x4*)(z + (size_t)row * NZ + ZKR + 8 * (ch - 8));
            }
            float fq[8], fk[8]; unpack8(wq, fq); unpack8(wk, fk);
            float sq = 0, sk = 0;
#pragma unroll
            for (int i = 0; i < 8; ++i) { sq += fq[i] * fq[i]; sk += fk[i] * fk[i]; }
#pragma unroll
            for (int o = 1; o < 16; o <<= 1) { sq += shx(sq, o, lane); sk += shx(sk, o, lane); }
            const float rq = 1.f / sqrtf(sq * (1.f / 96.f) + EPSN), rk = 1.f / sqrtf(sk * (1.f / 96.f) + EPSN);
            const int cch = ch < 12 ? ch : 0;
#pragma unroll
            for (int i = 0; i < 8; ++i) { fq[i] *= rq * gq[8 * cch + i]; fk[i] *= rk * gk[8 * cch + i]; }
#pragma unroll
            for (int i = 0; i < 8; ++i) {
                const float pq = shx(fq[i], 1, lane), pk = shx(fk[i], 1, lane);
                if (lat && ch >= 8 && ch < 12) {
                    const float c = rope[(pos * 8 + i) * 2], s = rope[(pos * 8 + i) * 2 + 1];
                    const float sg = (ch & 1) ? s : -s;
                    fq[i] = fq[i] * c + pq * sg; fk[i] = fk[i] * c + pk * sg;
                }
            }
            if (act) {
                if (doq) {
#pragma unroll
                    for (int i = 0; i < 8; ++i) fq[i] *= qs;
                    *(u32x4*)(Qm + (size_t)row * 576 + head * 96 + 8 * ch) = pack8(fq);
                }
                *(u32x4*)(Km + (size_t)row * 576 + head * 96 + 8 * ch) = pack8(fk);
            }
        }
    }
}

DI int s5_tok_row(int b, int cc, int s) { return cc < 16 ? TX + b * 256 + cc * 16 + s : b * 2048 + (cc - 16) * 16 + s; }
DI void s5_tables(const Params& P, int ldg, LAS unsigned char* lds, int tid) {
    LAS f32x2* pw = (LAS f32x2*)lds;
    LAS f32x2* bb = pw + 17 * 64;
    LAS f32x2* cc = bb + 64 * 16;
    LAS float* T = (LAS float*)(cc + 16 * 64);
    const int d = (ldg >> 4) & 1;
    unsigned char* ws = ows(P);
    if (tid < 64) {
        const int i = ldg * 64 + tid;
        const float lre = P.in[oidx(18)][i], lim = P.in[oidx(19)][i], dt = expf(P.in[oidx(20)][ldg]);
        const float er = expf(lre * dt), ang = lim * dt; const float lbr = er * cosf(ang), lbi = er * sinf(ang);
        const float nr = lbr - 1.f, ni = lbi, den = lre * lre + lim * lim;
        const float qr = (nr * lre + ni * lim) / den, qi = (ni * lre - nr * lim) / den;
        float wr = 1.f, wi = 0.f;
        for (int j = 0; j <= 16; ++j) { pw[j * 64 + tid] = (f32x2){wr, wi}; const float t = wr * lbr - wi * lbi; wi = wr * lbi + wi * lbr; wr = t; }
        ((f32x2*)(ws + OFF_S5L16))[i] = pw[16 * 64 + tid];
        for (int m = 0; m < 16; ++m) { const float br = P.in[oidx(21)][(size_t)i * 16 + m], bi = P.in[oidx(22)][(size_t)i * 16 + m]; bb[tid * 16 + m] = (f32x2){qr * br - qi * bi, qr * bi + qi * br}; }
    }
    for (int e = tid; e < 1024; e += 512) cc[e] = (f32x2){P.in[oidx(23)][(size_t)ldg * 1024 + e], P.in[oidx(24)][(size_t)ldg * 1024 + e]};
    __syncthreads();
    {
        const int m = (tid >> 4) & 15, mp = tid & 15, j0 = tid >> 8;
        float acc[8];
#pragma unroll
        for (int i = 0; i < 8; ++i) acc[i] = 0.f;
        for (int p = 0; p < 64; ++p) {
            const f32x2 c = cc[m * 64 + p], b = bb[p * 16 + mp];
            const float cbr = c.x * b.x - c.y * b.y, cbi = c.x * b.y + c.y * b.x;
#pragma unroll
            for (int i = 0; i < 8; ++i) { const f32x2 w = pw[(j0 + 2 * i) * 64 + p]; acc[i] += cbr * w.x - cbi * w.y; }
        }
#pragma unroll
        for (int i = 0; i < 8; ++i) T[((j0 + 2 * i) * 16 + m) * 16 + mp] = acc[i];
    }
    __syncthreads();
    bf16_t* Km = (bf16_t*)(ws + OFF_S5K) + (size_t)ldg * 65536;
    for (int ch = tid; ch < 8192; ch += 512) {
        const int row = ch >> 5, c0 = (ch & 31) * 8, t = row >> 4, m = row & 15, sx = c0 >> 4, mp0 = c0 & 15;
        const int lag = d == 0 ? t - sx : sx - t; float v[8];
#pragma unroll
        for (int i = 0; i < 8; ++i) v[i] = lag >= 0 ? T[(lag * 16 + m) * 16 + mp0 + i] : 0.f;
        *(u32x4*)(Km + (size_t)row * 256 + c0) = pack8(v);
    }
    bf16_t* Em = (bf16_t*)(ws + OFF_S5E) + (size_t)ldg * 32768;
    for (int ch = tid; ch < 4096; ch += 512) {
        const int row = ch >> 5, c0 = (ch & 31) * 8, p = row >> 1, c = row & 1, sx = c0 >> 4, mp0 = c0 & 15;
        const f32x2 w = pw[(d == 0 ? 15 - sx : sx) * 64 + p]; float v[8];
#pragma unroll
        for (int i = 0; i < 8; ++i) { const f32x2 b = bb[p * 16 + mp0 + i]; v[i] = c ? (w.x * b.y + w.y * b.x) : (w.x * b.x - w.y * b.y); }
        *(u32x4*)(Em + (size_t)row * 256 + c0) = pack8(v);
    }
    bf16_t* Fm = (bf16_t*)(ws + OFF_S5F) + (size_t)ldg * 32768;
    for (int ch = tid; ch < 4096; ch += 512) {
        const int row = ch >> 4, c0 = (ch & 15) * 8, t = row >> 4, m = row & 15, p0 = c0 >> 1; float v[8];
#pragma unroll
        for (int i = 0; i < 4; ++i) { const f32x2 w = pw[(d == 0 ? t + 1 : 16 - t) * 64 + p0 + i], c = cc[m * 64 + p0 + i];
            v[2 * i] = c.x * w.x - c.y * w.y; v[2 * i + 1] = -(c.x * w.y + c.y * w.x); }
        *(u32x4*)(Fm + (size_t)row * 128 + c0) = pack8(v);
    }
    __syncthreads();
}
DI void phase_s5_s1(const Params& P, int l) {
    const int tid_ = otid(); const int lane = tid_ & 63, fr = lane & 15, fq = lane >> 4, gw = (tid_ >> 6) * (int)gridDim.x + obid(), NGW = gridDim.x * 8;
    const bf16_t* z = (const bf16_t*)(ows(P) + OFF_Z);
    float* se = (float*)(ows(P) + OFF_SE);
    for (int it = gw; it < 2304; it += NGW) {
        const int cb = it % 72, gd = it / 72, d = gd & 1, g = gd >> 1, b = cb / 9, cc = 16 * (cb % 9) + fr;
        const bf16_t* Em = (const bf16_t*)(ows(P) + OFF_S5E) + (size_t)((l * 2 + d) * 16 + g) * 32768;
        bf16x8 uf[8];
#pragma unroll
        for (int ks = 0; ks < 8; ++ks) uf[ks] = *(const bf16x8*)(z + (size_t)s5_tok_row(b, cc, 2 * ks + (fq >> 1)) * NZ + ZU + 16 * g + 8 * (fq & 1));
        float* so = se + ((size_t)(((b * 16 + g) * 2 + d) * 144 + cc)) * 128 + 4 * fq;
#pragma unroll
        for (int rb = 0; rb < 8; ++rb) {
            bf16x8 a[8];
#pragma unroll
            for (int ks = 0; ks < 8; ++ks) a[ks] = *(const bf16x8*)(Em + (size_t)(rb * 16 + fr) * 256 + 32 * ks + 8 * fq);
            __builtin_amdgcn_sched_barrier(0);
            f32x4 acc = {0.f, 0.f, 0.f, 0.f};
#pragma unroll
            for (int ks = 0; ks < 8; ++ks) acc = __builtin_amdgcn_mfma_f32_16x16x32_bf16(a[ks], uf[ks], acc, 0, 0, 0);
            *(f32x4*)(so + 16 * rb) = acc;
            __builtin_amdgcn_sched_barrier(0);
        }
    }
}
DI void phase_s5_s2(const Params& P, int l, LAS unsigned char* lds) {
    const int tid_ = otid(); const int lane = tid_ & 63, wave = __builtin_amdgcn_readfirstlane(tid_ >> 6);
    const float* se = (const float*)(ows(P) + OFF_SE); bf16_t* hs = (bf16_t*)(ows(P) + OFF_SH);
    LAS f32x2* seg = (LAS f32x2*)lds;
    for (int line = obid(); line < 256; line += (int)gridDim.x) {
        const int d = line & 1, g = (line >> 1) & 15;
        const f32x2 lam = ((const f32x2*)(ows(P) + OFF_S5L16))[((l * 2 + d) * 16 + g) * 64 + lane];
        const float* sl = se + (size_t)line * 144 * 128 + 2 * lane; bf16_t* hl = hs + (size_t)line * 144 * 128 + 2 * lane;
        f32x2 ev[18];
#pragma unroll
        for (int i = 0; i < 18; ++i) { const int j = wave * 18 + i; const int cc = d == 0 ? j : (j < 16 ? 15 - j : 159 - j); ev[i] = *(const f32x2*)(sl + cc * 128); }
        float br = 0.f, bi = 0.f, ar = 1.f, ai = 0.f;
#pragma unroll
        for (int i = 0; i < 18; ++i) {
            const float nr = lam.x * br - lam.y * bi + ev[i].x, ni = lam.x * bi + lam.y * br + ev[i].y; br = nr; bi = ni;
            const float tr = lam.x * ar - lam.y * ai, ti = lam.x * ai + lam.y * ar; ar = tr; ai = ti;
        }
        seg[wave * 64 + lane] = (f32x2){br, bi};
        __syncthreads();
        float hr = 0.f, hi = 0.f;
        for (int sgi = 0; sgi < wave; ++sgi) { const f32x2 b2 = seg[sgi * 64 + lane]; const float nr = ar * hr - ai * hi + b2.x, ni = ar * hi + ai * hr + b2.y; hr = nr; hi = ni; }
#pragma unroll
        for (int i = 0; i < 18; ++i) {
            const int j = wave * 18 + i; const int cc = d == 0 ? j : (j < 16 ? 15 - j : 159 - j);
            *(unsigned*)(hl + cc * 128) = pk2(hr, hi);
            const float nr = lam.x * hr - lam.y * hi + ev[i].x, ni = lam.x * hi + lam.y * hr + ev[i].y; hr = nr; hi = ni;
        }
        __syncthreads();
    }
}
DI void phase_s5_s3(const Params& P, int l) {
    const int tid_ = otid(); const int lane = tid_ & 63, fr = lane & 15, fq = lane >> 4, gw = (tid_ >> 6) * (int)gridDim.x + obid(), NGW = gridDim.x * 8;
    const bf16_t* z = (const bf16_t*)(ows(P) + OFF_Z); const bf16_t* hs = (const bf16_t*)(ows(P) + OFF_SH); bf16_t* yb = (bf16_t*)(ows(P) + OFF_YB);
    for (int it = gw; it < 1152; it += NGW) {
        const int cbl = it % 9, b = (it / 9) & 7, g = it / 72;
        if (l == 1 && cbl == 0) continue;
        const int cc = 16 * cbl + fr;
        bf16x8 uf[8];
#pragma unroll
        for (int ks = 0; ks < 8; ++ks) uf[ks] = *(const bf16x8*)(z + (size_t)s5_tok_row(b, cc, 2 * ks + (fq >> 1)) * NZ + ZU + 16 * g + 8 * (fq & 1));
        f32x4 y[16];
#pragma unroll
        for (int t = 0; t < 16; ++t) y[t] = (f32x4){0.f, 0.f, 0.f, 0.f};
        const int ldg0 = (l * 2 + 0) * 16 + g;
        const bf16_t* Km0 = (const bf16_t*)(ows(P) + OFF_S5K) + (size_t)ldg0 * 65536 + (size_t)fr * 256 + 8 * fq;
        const bf16_t* Fm0 = (const bf16_t*)(ows(P) + OFF_S5F) + (size_t)ldg0 * 32768 + (size_t)fr * 128 + 8 * fq;
        const bf16_t* hp0 = hs + ((size_t)(((b * 16 + g) * 2 + 0) * 144 + cc)) * 128 + 8 * fq;
        bf16x8 hf[2][4];
#pragma unroll
        for (int d = 0; d < 2; ++d)
#pragma unroll
            for (int ks = 0; ks < 4; ++ks) hf[d][ks] = *(const bf16x8*)(hp0 + (size_t)d * 144 * 128 + 32 * ks);
#pragma unroll
        for (int t = 0; t < 16; ++t) {
            bf16x8 a[24]; int n = 0;
#pragma unroll
            for (int d = 0; d < 2; ++d) {
#pragma unroll
                for (int ks = 0; ks < 8; ++ks) if (d == 0 ? (2 * ks <= t) : (2 * ks + 1 >= t)) a[n++] = *(const bf16x8*)(Km0 + (size_t)d * 16 * 65536 + (size_t)t * 16 * 256 + 32 * ks);
#pragma unroll
                for (int ks = 0; ks < 4; ++ks) a[n++] = *(const bf16x8*)(Fm0 + (size_t)d * 16 * 32768 + (size_t)t * 16 * 128 + 32 * ks);
            }
            __builtin_amdgcn_sched_barrier(0);
            n = 0;
#pragma unroll
            for (int d = 0; d < 2; ++d) {
#pragma unroll
                for (int ks = 0; ks < 8; ++ks) if (d == 0 ? (2 * ks <= t) : (2 * ks + 1 >= t)) y[t] = __builtin_amdgcn_mfma_f32_16x16x32_bf16(a[n++], uf[ks], y[t], 0, 0, 0);
#pragma unroll
                for (int ks = 0; ks < 4; ++ks) y[t] = __builtin_amdgcn_mfma_f32_16x16x32_bf16(a[n++], hf[d][ks], y[t], 0, 0, 0);
            }
            __builtin_amdgcn_sched_barrier(0);
        }
        const f32x4 dv = *(const f32x4*)(P.in[oidx(25)] + l * 256 + 16 * g + 4 * fq);
#pragma unroll
        for (int t = 0; t < 16; ++t) {
            const size_t row = (size_t)s5_tok_row(b, cc, t);
            const u32x2 uw = *(const u32x2*)(z + row * NZ + ZU + 16 * g + 4 * fq);
            const f32x4 u = {bflo(uw.x), bfhi(uw.x), bflo(uw.y), bfhi(uw.y)};
            const f32x4 v = y[t] + dv * u;
            u32x2 w; w.x = pk2(gelu_tanh_f(v.x), gelu_tanh_f(v.y)); w.y = pk2(gelu_tanh_f(v.z), gelu_tanh_f(v.w));
            *(u32x2*)(yb + row * 256 + 16 * g + 4 * fq) = w;
        }
    }
}

template <int DQK, int MODE>
DI void attn_item(const Params& P, int l, int b, int h, int qb, LAS unsigned char* lds) {
    constexpr int KSTR = DQK * 2 + 16, NKS = DQK / 16, KCH = DQK / 8;
    constexpr int VS_OFF = 64 * 208, VSTR = 136, RPB_OFF = VS_OFF + 64 * 144;
    const int tid = otid(), wave = __builtin_amdgcn_readfirstlane(tid >> 6), lane = tid & 63, q = lane & 31, hh = lane >> 5;
    const bf16_t* Qg; const bf16_t* Kg; const bf16_t* Vt; int ldq, ldk, ocol;
    if (DQK == 96) { Qg = (const bf16_t*)(ows(P) + OFF_QM) + h * 96; ldq = 576; Kg = (const bf16_t*)(ows(P) + OFF_KM) + h * 96; ldk = 576; Vt = (const bf16_t*)(ows(P) + OFF_VTM) + (size_t)h * 64 * TT; ocol = 384 + h * 64; }
    else { Qg = (const bf16_t*)(ows(P) + OFF_Z) + ZQA + h * 64; ldq = NZ; Kg = (const bf16_t*)(ows(P) + OFF_Z) + ZKA + h * 64; ldk = NZ; Vt = (const bf16_t*)(ows(P) + OFF_VTA) + (size_t)h * 64 * TT; ocol = h * 64; }
    int qrow0, ntiles, rmin = 0, rq = 0, rs = 0;
    if (MODE == 0) { qrow0 = b * 2048 + 256 * qb + 32 * wave; ntiles = 36; }
    else if (MODE == 1) { rq = 4 * qb + (wave >> 1); qrow0 = b * 2048 + 64 * rq + 32 * (wave & 1);
        rmin = min(max(4 * qb - 4, 0), 24); const int rmax = min(max(4 * qb + 3 - 4, 0), 24) + 7; ntiles = 4 + (rmax - rmin + 1); rs = min(max(rq - 4, 0), 24); }
    else { qrow0 = TX + b * 256 + 32 * wave; ntiles = oidx(4); }
    if (MODE == 1) {
        const float* rp = P.in[oidx(12)] + (size_t)(l * 6 + h) * 465;
        for (int i = tid; i < 465; i += 512) ((LAS float*)(lds + RPB_OFF))[i] = rp[i] * LOG2E;
    }
    bf16x8 bq[NKS];
    { const bf16_t* qp = Qg + (size_t)(qrow0 + q) * ldq + 8 * hh;
#pragma unroll
      for (int ks = 0; ks < NKS; ++ks) bq[ks] = *(const bf16x8*)(qp + 16 * ks); }
    f32x16 O0, O1;
#pragma unroll
    for (int i = 0; i < 16; ++i) { O0[i] = 0.f; O1[i] = 0.f; }
    float lsum = 0.f;
    const int cq = 32 * (wave & 1) + q, cs = min(max(cq - 8, 0), 48);
    auto tile_row = [&](int i) -> int { if (i < 4) return TX + b * 256 + 64 * i; if (MODE == 1) return b * 2048 + 64 * (rmin + i - 4); return b * 2048 + 64 * (i - 4); };
    u32x4 pk0, pk1 = {0, 0, 0, 0}, pv;
    auto prefetch = [&](int i) {
        const int r0 = tile_row(i);
        { const int c = tid, row = c / KCH, cc = c % KCH; pk0 = *(const u32x4*)(Kg + (size_t)(r0 + row) * ldk + 8 * cc); }
        if (DQK == 96) { const int c = tid + 512; if (c < 64 * KCH) { const int row = c / KCH, cc = c % KCH; pk1 = *(const u32x4*)(Kg + (size_t)(r0 + row) * ldk + 8 * cc); } }
        { const int dv = tid >> 3, cc = tid & 7; pv = *(const u32x4*)(Vt + (size_t)dv * TT + r0 + 8 * cc); }
    };
    prefetch(0);
    for (int i = 0; i < ntiles; ++i) {
        __syncthreads();
        { const int c = tid, row = c / KCH, cc = c % KCH; *(LAS u32x4*)(lds + row * KSTR + 16 * cc) = pk0; }
        if (DQK == 96) { const int c = tid + 512; if (c < 64 * KCH) { const int row = c / KCH, cc = c % KCH; *(LAS u32x4*)(lds + row * KSTR + 16 * cc) = pk1; } }
        { const int dv = tid >> 3, cc = tid & 7; LAS u32x2* vp = (LAS u32x2*)(lds + VS_OFF + dv * VSTR + 16 * cc); vp[0] = (u32x2){pv.x, pv.y}; vp[1] = (u32x2){pv.z, pv.w}; }
        __syncthreads();
        if (i + 1 < ntiles) prefetch(i + 1);
        bool active = true; int kr = 0;
        if (MODE == 1 && i >= 4) { kr = rmin + i - 4; active = (kr >= rs) && (kr < rs + 8); }
        if (!active) continue;
        f32x16 s0, s1;
#pragma unroll
        for (int j = 0; j < 16; ++j) { s0[j] = 0.f; s1[j] = 0.f; }
        {
            constexpr int HK = 2;
#pragma unroll
            for (int hf = 0; hf < NKS / 2; ++hf) {
                bf16x8 ka0[HK], ka1[HK];
#pragma unroll
                for (int k2 = 0; k2 < HK; ++k2) { const int ks = hf * HK + k2; ka0[k2] = *(const LAS bf16x8*)(lds + q * KSTR + 32 * ks + 16 * hh); ka1[k2] = *(const LAS bf16x8*)(lds + (32 + q) * KSTR + 32 * ks + 16 * hh); }
                __builtin_amdgcn_sched_barrier(0);
#pragma unroll
                for (int k2 = 0; k2 < HK; ++k2) { const int ks = hf * HK + k2;
                    s0 = __builtin_amdgcn_mfma_f32_32x32x16_bf16(ka0[k2], bq[ks], s0, 0, 0, 0);
                    s1 = __builtin_amdgcn_mfma_f32_32x32x16_bf16(ka1[k2], bq[ks], s1, 0, 0, 0); }
                __builtin_amdgcn_sched_barrier(0);
            }
        }
        s16x4 vlo[2][2][2], vhi[2][2][2];
#pragma unroll
        for (int sp = 0; sp < 2; ++sp)
#pragma unroll
            for (int dvb = 0; dvb < 2; ++dvb) {
                const int off = VS_OFF + (32 * dvb + q) * VSTR + (16 * sp + 4 * hh) * 2;
                vlo[0][sp][dvb] = *(const LAS s16x4*)(lds + off); vhi[0][sp][dvb] = *(const LAS s16x4*)(lds + off + 16);
            }
        __builtin_amdgcn_sched_barrier(0);
        if (MODE == 1 && i >= 4) {
            const LAS float* rb = (const LAS float*)(lds + RPB_OFF) + (kr - rq + 7) * 31;
#pragma unroll
            for (int j = 0; j < 16; ++j) {
                const int kc0 = (j & 3) + 8 * (j >> 2) + 4 * hh, kc1 = kc0 + 32;
                const int i0 = min(max(kc0 - cq + 15, 0), 30), i1 = min(max(kc1 - cq + 15, 0), 30);
                const float b0 = rb[i0], b1 = rb[i1];
                s0[j] = (kc0 >= cs && kc0 < cs + 16) ? s0[j] + b0 : -1e30f;
                s1[j] = (kc1 >= cs && kc1 < cs + 16) ? s1[j] + b1 : -1e30f;
            }
        }
        float ps = 0.f;
#pragma unroll
        for (int j = 0; j < 16; ++j) { s0[j] = fast_exp2(s0[j]); s1[j] = fast_exp2(s1[j]); ps += s0[j] + s1[j]; }
        lsum += ps;
        bf16x8 bp[2][2];
#pragma unroll
        for (int sp = 0; sp < 2; ++sp) {
            u32x4 pw;
            pw.x = pk2(s0[8 * sp + 0], s0[8 * sp + 1]); pw.y = pk2(s0[8 * sp + 2], s0[8 * sp + 3]); pw.z = pk2(s0[8 * sp + 4], s0[8 * sp + 5]); pw.w = pk2(s0[8 * sp + 6], s0[8 * sp + 7]);
            bp[0][sp] = __builtin_bit_cast(bf16x8, pw);
            pw.x = pk2(s1[8 * sp + 0], s1[8 * sp + 1]); pw.y = pk2(s1[8 * sp + 2], s1[8 * sp + 3]); pw.z = pk2(s1[8 * sp + 4], s1[8 * sp + 5]); pw.w = pk2(s1[8 * sp + 6], s1[8 * sp + 7]);
            bp[1][sp] = __builtin_bit_cast(bf16x8, pw);
        }
        __builtin_amdgcn_sched_barrier(0);
#pragma unroll
        for (int sp = 0; sp < 2; ++sp)
#pragma unroll
            for (int dvb = 0; dvb < 2; ++dvb) {
                const int off = VS_OFF + (32 * dvb + q) * VSTR + (32 + 16 * sp + 4 * hh) * 2;
                vlo[1][sp][dvb] = *(const LAS s16x4*)(lds + off); vhi[1][sp][dvb] = *(const LAS s16x4*)(lds + off + 16);
            }
        __builtin_amdgcn_sched_barrier(0);
#pragma unroll
        for (int kb = 0; kb < 2; ++kb)
#pragma unroll
            for (int sp = 0; sp < 2; ++sp) {
                const bf16x8 av0 = __builtin_shufflevector(vlo[kb][sp][0], vhi[kb][sp][0], 0, 1, 2, 3, 4, 5, 6, 7), av1 = __builtin_shufflevector(vlo[kb][sp][1], vhi[kb][sp][1], 0, 1, 2, 3, 4, 5, 6, 7);
                O0 = __builtin_amdgcn_mfma_f32_32x32x16_bf16(av0, bp[kb][sp], O0, 0, 0, 0);
                O1 = __builtin_amdgcn_mfma_f32_32x32x16_bf16(av1, bp[kb][sp], O1, 0, 0, 0);
            }
    }
    lsum += shx(lsum, 32, lane);
    const float inv = 1.f / lsum;
    bf16_t* op = (bf16_t*)(ows(P) + OFF_OX) + (size_t)(qrow0 + q) * DM + ocol + 4 * hh;
#pragma unroll
    for (int g4 = 0; g4 < 4; ++g4) {
        u32x2 w0, w1;
        w0.x = pk2(O0[4 * g4] * inv, O0[4 * g4 + 1] * inv); w0.y = pk2(O0[4 * g4 + 2] * inv, O0[4 * g4 + 3] * inv);
        w1.x = pk2(O1[4 * g4] * inv, O1[4 * g4 + 1] * inv); w1.y = pk2(O1[4 * g4 + 2] * inv, O1[4 * g4 + 3] * inv);
        *(u32x2*)(op + 8 * g4) = w0; *(u32x2*)(op + 32 + 8 * g4) = w1;
    }
    __syncthreads();
}
DI void phase_attn(const Params& P, int l, LAS unsigned char* lds, volatile LAS unsigned* itw, int slot) {
    unsigned* ctr = (unsigned*)(ows(P) + OFF_CTR) + 16 * slot;
    const int nit = 384 + 384 + (l == 0 ? 96 : 0);
    for (;;) {
        __syncthreads();
        if (threadIdx.x == 0) *itw = atomicAdd(ctr, 1u);
        __syncthreads();
        const int it = (int)*itw;
        if (it >= nit) break;
        if (it < 384) { const int qb = it & 7, h = (it >> 3) % 6, b = it / 48; attn_item<96, 0>(P, l, b, h, qb, lds); }
        else if (it < 768) { const int j = it - 384; const int qb = j & 7, h = (j >> 3) % 6, b = j / 48; attn_item<64, 1>(P, l, b, h, qb, lds); }
        else { const int j = it - 768; const int hd = j % 12, b = j / 12; if (hd < 6) attn_item<64, 2>(P, l, b, hd, 0, lds); else attn_item<96, 2>(P, l, b, hd - 6, 0, lds); }
    }
}

__global__ void __launch_bounds__(512, 2) fwd_megakernel(Params P) {
    extern __shared__ __attribute__((aligned(16))) unsigned char smem[];
    __shared__ __attribute__((aligned(16))) unsigned sh_words[4];
    LAS unsigned char* lds = (LAS unsigned char*)smem;
    if (threadIdx.x < 4) sh_words[threadIdx.x] = 0u;
    __syncthreads();
    XcdBarrier xb = xcd_barrier_post((unsigned*)(ows(P) + OFF_BAR), (volatile LAS unsigned*)sh_words);
    volatile LAS unsigned* itw = (volatile LAS unsigned*)sh_words + 2;

    phase_prep(P, lds);
    if (P.ws == nullptr) cg::this_grid().sync();
    xcd_barrier(xb);

    for (int l = 0; l < 2; ++l) {
        const float* ml = (const float*)(ows(P) + OFF_MODS) + (size_t)l * 9 * 9216;
        const float* sx = l == 0 ? P.in[oidx(0)] : P.out; float* sc = ((float*)(ows(P) + OFF_HXC));
        const int M2 = l == 0 ? TT : TX;
        phase_modulate(sx, sc, TT, P.in[oidx(6)] + (l * 3 + 0) * 1024, ml + 0 * 1024, ml + 1 * 1024, ((bf16_t*)(ows(P) + OFF_A)), l == 1 ? (const float*)(ows(P) + OFF_OX) : (const float*)nullptr);
        xcd_barrier(xb);
        { pg8::EpiSwiglu e; e.H = ((bf16_t*)(ows(P) + OFF_H)); e.ldh = DFF; gemm_call(lds, ((bf16_t*)(ows(P) + OFF_A)), DM, (const bf16_t*)(ows(P) + OFF_WGU) + (size_t)(l * 2 + 0) * 5632 * 1024, 1024, TT, 5632, 1024, e, 0); }
        if (gridDim.x == 256) deferred_transposes(P, lds, l == 0 ? 0 : 99, 48);
        xcd_barrier(xb);
        { pg8::EpiResid e; e.rin_x = sx; e.rin_c = sc; e.rout_x = P.out; e.rout_c = ((float*)(ows(P) + OFF_HXC)); e.gate = ml + 2 * 1024; e.gs = 0.5f;
          gemm_call(lds, ((bf16_t*)(ows(P) + OFF_H)), DFF, (const bf16_t*)(ows(P) + OFF_WDN) + (size_t)(l * 2 + 0) * 1024 * 2816, 2816, TX, 1024, 2816, e, 0); }
        for (int kq = 0; kq < 4; ++kq) {
          const int koff = kq < 2 ? 768 * kq : 1536 + 640 * (kq - 2), klen = kq < 2 ? 768 : 640;
          pg8::EpiResidAtomicC e; e.rout_c = ((float*)(ows(P) + OFF_OX)) + (size_t)kq * TC * DM; e.gate = ml + 2 * 1024; e.gs = 0.5f;
          gemm_call(lds, ((bf16_t*)(ows(P) + OFF_H)) + (size_t)TX * DFF + koff, DFF, (const bf16_t*)(ows(P) + OFF_WDN) + (size_t)(l * 2 + 0) * 1024 * 2816 + koff, 2816, TC, 1024, klen, e, 256 - 32 * kq); }
        if (gridDim.x == 256) deferred_transposes(P, lds, l == 0 ? 1 : 99, 128);
        xcd_barrier(xb);
        phase_modulate(P.out, ((float*)(ows(P) + OFF_HXC)), TT, P.in[oidx(6)] + (l * 3 + 1) * 1024, ml + 3 * 1024, ml + 4 * 1024, ((bf16_t*)(ows(P) + OFF_A)), (const float*)(ows(P) + OFF_OX));
        xcd_barrier(xb);
        { pg8::EpiStore e; e.O = ((bf16_t*)(ows(P) + OFF_Z)); e.ldo = NZ; e.rows_valid = TT; e.cols_valid = NZ; e.kmap = 0;
          gemm_call(lds, ((bf16_t*)(ows(P) + OFF_A)), DM, (const bf16_t*)(ows(P) + OFF_WIN) + (size_t)l * NZ * 1024, 1024, TT, NZ, 1024, e, 0); }
        xcd_barrier(xb);
        phase_znorm(P, l);
        phase_s5_s1(P, l);
        xcd_barrier(xb);
        phase_s5_s2(P, l, lds);
        { pg8::EpiStore e; e.O = (bf16_t*)(ows(P) + OFF_QM); e.ldo = 576; e.rows_valid = TT; e.cols_valid = 576; e.kmap = 0;
          gemm_call(lds, ((bf16_t*)(ows(P) + OFF_Z)) + ZCQ, NZ, (const bf16_t*)(ows(P) + OFF_WUQ) + (size_t)l * 768 * 384, 384, l == 0 ? TT : TX, 768, 384, e, 0); }
        { pg8::EpiStore e; e.O = (bf16_t*)(ows(P) + OFF_KM); e.ldo = 576; e.rows_valid = TT; e.cols_valid = 384; e.kmap = 1;
          gemm_call(lds, ((bf16_t*)(ows(P) + OFF_Z)) + ZCKV, NZ, (const bf16_t*)(ows(P) + OFF_WUK) + (size_t)l * 512 * 256, 256, TT, 512, 256, e, 40); }
        { pg8::EpiStore e; e.O = (bf16_t*)(ows(P) + OFF_VTM); e.ldo = TT; e.rows_valid = 384; e.cols_valid = TT; e.kmap = 0;
          gemm_call(lds, (const bf16_t*)(ows(P) + OFF_WUV) + (size_t)l * 512 * 256, 256, ((bf16_t*)(ows(P) + OFF_Z)) + ZCKV, NZ, 512, TT, 256, e, 152); }
        { pg8::EpiStore e; e.O = (bf16_t*)(ows(P) + OFF_VTA); e.ldo = TT; e.rows_valid = 384; e.cols_valid = TT; e.kmap = 0;
          gemm_call(lds, (const bf16_t*)(ows(P) + OFF_WVA) + (size_t)l * 512 * 1024, 1024, ((bf16_t*)(ows(P) + OFF_A)), DM, 512, TT, 1024, e, 8); }
        xcd_barrier(xb);
        phase_finish(P, l);
        phase_s5_s3(P, l);
        xcd_barrier(xb);
        { pg8::EpiGlu e; e.O = ((bf16_t*)(ows(P) + OFF_OX)); e.ldo = DM; e.col_base = 768; e.bias = P.in[oidx(27)] + l * 512;
          gemm_call(lds, (const bf16_t*)(ows(P) + OFF_YB), 256, (const bf16_t*)(ows(P) + OFF_WGLU) + (size_t)l * 512 * 256, 256, M2, 512, 256, e, 0); }
        phase_attn(P, l, lds, itw, l * 2 + 1);
        xcd_barrier(xb);
        { pg8::EpiResid e; e.rin_x = P.out; e.rin_c = ((float*)(ows(P) + OFF_HXC)); e.rout_x = P.out; e.rout_c = ((float*)(ows(P) + OFF_HXC)); e.gate = ml + 5 * 1024; e.gs = 1.0f;
          gemm_call(lds, ((bf16_t*)(ows(P) + OFF_OX)), DM, (const bf16_t*)(ows(P) + OFF_WOUT) + (size_t)l * 1024 * 1024, 1024, TX, 1024, 1024, e, 0); }
        if (l == 0) for (int kq = 0; kq < 4; ++kq) {
          pg8::EpiResidAtomicC e; e.rout_c = ((float*)(ows(P) + OFF_Z)) + (size_t)kq * TC * DM; e.gate = ml + 5 * 1024; e.gs = 1.0f;
          gemm_call(lds, ((bf16_t*)(ows(P) + OFF_OX)) + (size_t)TX * DM + kq * 256, DM, (const bf16_t*)(ows(P) + OFF_WOUT) + (size_t)l * 1024 * 1024 + kq * 256, 1024, TC, 1024, 256, e, 256 - 32 * kq); }
        xcd_barrier(xb);
        phase_modulate(P.out, ((float*)(ows(P) + OFF_HXC)), M2, P.in[oidx(6)] + (l * 3 + 2) * 1024, ml + 6 * 1024, ml + 7 * 1024, ((bf16_t*)(ows(P) + OFF_A)), l == 0 ? (const float*)(ows(P) + OFF_Z) : (const float*)nullptr);
        xcd_barrier(xb);
        { pg8::EpiSwiglu e; e.H = ((bf16_t*)(ows(P) + OFF_H)); e.ldh = DFF; gemm_call(lds, ((bf16_t*)(ows(P) + OFF_A)), DM, (const bf16_t*)(ows(P) + OFF_WGU) + (size_t)(l * 2 + 1) * 5632 * 1024, 1024, M2, 5632, 1024, e, 0); }
        if (gridDim.x == 256) deferred_transposes(P, lds, l == 0 ? 2 : 99, 48);
        xcd_barrier(xb);
        { pg8::EpiResid e; e.rin_x = P.out; e.rin_c = ((float*)(ows(P) + OFF_HXC)); e.rout_x = P.out; e.rout_c = ((float*)(ows(P) + OFF_HXC)); e.gate = ml + 8 * 1024; e.gs = 0.5f;
          gemm_call(lds, ((bf16_t*)(ows(P) + OFF_H)), DFF, (const bf16_t*)(ows(P) + OFF_WDN) + (size_t)(l * 2 + 1) * 1024 * 2816, 2816, TX, 1024, 2816, e, 0); }
        if (l == 0) for (int kq = 0; kq < 4; ++kq) {
          const int koff = kq < 2 ? 768 * kq : 1536 + 640 * (kq - 2), klen = kq < 2 ? 768 : 640;
          pg8::EpiResidAtomicC e; e.rout_c = ((float*)(ows(P) + OFF_OX)) + (size_t)kq * TC * DM; e.gate = ml + 8 * 1024; e.gs = 0.5f;
          gemm_call(lds, ((bf16_t*)(ows(P) + OFF_H)) + (size_t)TX * DFF + koff, DFF, (const bf16_t*)(ows(P) + OFF_WDN) + (size_t)(l * 2 + 1) * 1024 * 2816 + koff, 2816, TC, 1024, klen, e, 256 - 32 * kq); }
        if (gridDim.x == 256) deferred_transposes(P, lds, l == 0 ? 3 : 99, 128);
        if (l == 0) xcd_barrier(xb);
    }
}

constexpr int LDS_BYTES = 131072;
extern "C" void kernel_launch(void* const* d_in, const int* in_sizes, int n_in, void* d_out, int out_size, void* d_ws, size_t ws_size, hipStream_t stream) {
    static int grid = 0;
    if (grid == 0) {
        if (n_in != 28 || ws_size < WS_END) { fprintf(stderr, "kernel_launch: unexpected inputs (n_in %d, ws %zu < %zu)\n", n_in, ws_size, (size_t)WS_END); grid = -1; return; }
        int dev = 0, cus = 0, per_cu = 0;
        hipGetDevice(&dev); hipDeviceGetAttribute(&cus, hipDeviceAttributeMultiprocessorCount, dev);
        if (hipFuncSetAttribute((const void*)fwd_megakernel, hipFuncAttributeMaxDynamicSharedMemorySize, LDS_BYTES) != hipSuccess) { fprintf(stderr, "kernel_launch: hipFuncSetAttribute failed\n"); grid = -1; return; }
        hipOccupancyMaxActiveBlocksPerMultiprocessor(&per_cu, (const void*)fwd_megakernel, 512, LDS_BYTES);
        if (per_cu < 1) { fprintf(stderr, "kernel_launch: occupancy query says %d\n", per_cu); per_cu = 1; }
        (void)hipGetLastError();
        grid = cus;
    }
    if (grid < 0) return;
    hipMemsetAsync((char*)d_ws + OFF_BAR, 0, 20480, stream);
    Params p{};
    for (int i = 0; i < 28; ++i) p.in[i] = (const float*)d_in[i];
    p.out = (float*)d_out; p.ws = (unsigned char*)d_ws;
    void* args[] = {&p};
    hipError_t e = hipLaunchCooperativeKernel((const void*)fwd_megakernel, dim3(grid), dim3(512), args, LDS_BYTES, stream);
    if (e != hipSuccess) fprintf(stderr, "cooperative launch failed: %s (grid %d)\n", hipGetErrorString(e), grid);
}
```

```cpp
#include <hip/hip_runtime.h>
#include <hip/hip_cooperative_groups.h>
#include <cstdio>
namespace cg = cooperative_groups;

#define LAS __attribute__((address_space(3)))
#define DI __device__ __forceinline__
typedef unsigned short bf16_t;
typedef short bf16x8 __attribute__((ext_vector_type(8)));
typedef short s16x4 __attribute__((ext_vector_type(4)));
typedef float f32x2 __attribute__((ext_vector_type(2)));
typedef float f32x4 __attribute__((ext_vector_type(4)));
typedef float f32x16 __attribute__((ext_vector_type(16)));
typedef unsigned u32x2 __attribute__((ext_vector_type(2)));
typedef unsigned u32x4 __attribute__((ext_vector_type(4)));
typedef __bf16 bf2_t __attribute__((ext_vector_type(2)));

constexpr int DM = 1024, NB = 8, SEQ = 2048, CTXL = 256;
constexpr int TX = NB * SEQ, TC = NB * CTXL, TT = TX + TC;
constexpr int DFF = 2816, NZ = 1792;
constexpr int ZQA = 0, ZKA = 384, ZCQ = 768, ZCKV = 1152, ZKR = 1408, ZU = 1440;
constexpr float EPSN = 1e-6f, LOG2E = 1.4426950408889634f;
constexpr int NCH = 36;

constexpr size_t SZ_WGU = (size_t)4 * 5632 * 1024 * 2, SZ_WDN = (size_t)4 * 1024 * 2816 * 2, SZ_WIN = (size_t)2 * NZ * 1024 * 2;
constexpr size_t SZ_WVA = (size_t)2 * 512 * 1024 * 2, SZ_WOUT = (size_t)2 * 1024 * 1024 * 2, SZ_WUQ = (size_t)2 * 768 * 384 * 2;
constexpr size_t SZ_WUK = (size_t)2 * 512 * 256 * 2, SZ_WUV = SZ_WUK, SZ_WGLU = SZ_WUK;
constexpr size_t OFF_BAR = 0;
constexpr size_t OFF_CTR = 16384;
constexpr size_t OFF_WGU = 20480;
constexpr size_t OFF_WDN = OFF_WGU + SZ_WGU;
constexpr size_t OFF_WIN = OFF_WDN + SZ_WDN;
constexpr size_t OFF_WVA = OFF_WIN + SZ_WIN;
constexpr size_t OFF_WOUT = OFF_WVA + SZ_WVA;
constexpr size_t OFF_WUQ = OFF_WOUT + SZ_WOUT;
constexpr size_t OFF_WUK = OFF_WUQ + SZ_WUQ;
constexpr size_t OFF_WUV = OFF_WUK + SZ_WUK;
constexpr size_t OFF_WGLU = OFF_WUV + SZ_WUV;
constexpr size_t OFF_MODS = OFF_WGLU + SZ_WGLU;
constexpr size_t OFF_ROPE = OFF_MODS + 663552;
constexpr size_t OFF_S5LAM = OFF_ROPE + 4096;
constexpr size_t OFF_S5BB = OFF_S5LAM + 65536;
constexpr size_t OFF_S5CA = OFF_S5BB + 524288;
constexpr size_t OFF_HXC = OFF_S5CA + 262144;
constexpr size_t OFF_A = OFF_HXC + (size_t)TC * DM * 4;
constexpr size_t OFF_OX = OFF_A + (size_t)TT * DM * 2;
constexpr size_t OFF_H = OFF_OX + (size_t)TT * DM * 2;
constexpr size_t OFF_Z = OFF_H;
constexpr size_t OFF_QM = OFF_Z + (size_t)TT * NZ * 2;
constexpr size_t OFF_VTA = OFF_QM + (size_t)TT * 576 * 2;
constexpr size_t OFF_KM = OFF_H + (size_t)TT * DFF * 2;
constexpr size_t OFF_VTM = OFF_KM + (size_t)TT * 576 * 2;
constexpr size_t OFF_YB = OFF_VTM + (size_t)384 * TT * 2;
constexpr size_t OFF_S5K = OFF_YB + (size_t)TT * 256 * 2;
constexpr size_t OFF_S5E = OFF_S5K + (size_t)64 * 65536 * 2;
constexpr size_t OFF_S5F = OFF_S5E + (size_t)64 * 32768 * 2;
constexpr size_t OFF_S5L16 = OFF_S5F + (size_t)64 * 32768 * 2;
constexpr size_t WS_END = OFF_S5L16 + (size_t)64 * 64 * 8;
static_assert((size_t)4 * TC * DM * 4 <= (size_t)TT * DM * 2, "slab alias overflow");
static_assert(WS_END <= (size_t)352 * 1024 * 1024, "workspace above the guaranteed 4 x largest tensor");
constexpr size_t OFF_SE = OFF_OX;
constexpr size_t OFF_SH = OFF_OX + (size_t)8 * 16 * 2 * 144 * 128 * 4;
static_assert((size_t)8 * 16 * 2 * 144 * 128 * 6 <= (size_t)TT * DM * 2, "S5 alias overflow");
static_assert(OFF_VTA + (size_t)384 * TT * 2 <= OFF_KM, "alias overflow");

struct Params { const float* in[28]; float* out; unsigned char* ws; };

DI unsigned char* ows(const Params& P) { unsigned zero = 0; asm volatile("" : "+s"(zero)); return P.ws + zero; }
DI unsigned pk2(float a, float b) { f32x2 v; v.x = a; v.y = b; return __builtin_bit_cast(unsigned, __builtin_convertvector(v, bf2_t)); }
DI float bflo(unsigned w) { return __uint_as_float(w << 16); }
DI float bfhi(unsigned w) { return __uint_as_float(w & 0xffff0000u); }
DI void unpack8(const u32x4 w, float (&f)[8]) { f[0] = bflo(w.x); f[1] = bfhi(w.x); f[2] = bflo(w.y); f[3] = bfhi(w.y); f[4] = bflo(w.z); f[5] = bfhi(w.z); f[6] = bflo(w.w); f[7] = bfhi(w.w); }
DI u32x4 pack8(const float (&f)[8]) { u32x4 w; w.x = pk2(f[0], f[1]); w.y = pk2(f[2], f[3]); w.z = pk2(f[4], f[5]); w.w = pk2(f[6], f[7]); return w; }
DI float shx(float v, int o, int lane) { return __int_as_float(__builtin_amdgcn_ds_bpermute((lane ^ o) << 2, __float_as_int(v))); }
DI float wave_sum(float v, int lane) {
#pragma unroll
    for (int o = 1; o < 64; o <<= 1) v += shx(v, o, lane);
    return v;
}
DI float fast_exp2(float x) { return __builtin_amdgcn_exp2f(x); }
DI float fast_rcp(float x) { return __builtin_amdgcn_rcpf(x); }
DI float silu_f(float x) { return x * fast_rcp(1.f + fast_exp2(-x * LOG2E)); }
DI float sigmoid_f(float x) { return fast_rcp(1.f + fast_exp2(-x * LOG2E)); }
DI float gelu_tanh_f(float y) { const float t = 0.7978845608028654f * (y + 0.044715f * y * y * y); const float e = fast_exp2(2.f * LOG2E * t); const float th = 1.f - 2.f * fast_rcp(e + 1.f); return 0.5f * y * (1.f + th); }
#define LDS_WAIT() asm volatile("s_waitcnt lgkmcnt(0)" ::: "memory")
DI int otid() { int t = threadIdx.x; asm volatile("" : "+v"(t)); return t; }
DI int oidx(int i) { asm volatile("" : "+s"(i)); return i; }
DI int obid() { int b = blockIdx.x; asm volatile("" : "+s"(b)); return b; }

#define XB_TMO      128
#define XB_XCNT(j)  (256  + 64 * (j))
#define XB_XSUB(j)  (1280 + 64 * (j))
#define XB_XGEN(j)  (2304 + 64 * (j))
#define XB_TOP      3328
#define XB_TOPGEN   3392
#define XCD_BAR_WORDS 3456
#define XB_SPIN_CAP (1u << 20)
DI unsigned xb_ld(unsigned* p) { return __hip_atomic_load(p, __ATOMIC_RELAXED, __HIP_MEMORY_SCOPE_AGENT); }
DI unsigned xb_add(unsigned* p, unsigned v) { return __hip_atomic_fetch_add(p, v, __ATOMIC_RELAXED, __HIP_MEMORY_SCOPE_AGENT); }
DI unsigned xb_xcc_id() { return (unsigned)__builtin_amdgcn_s_getreg((3 << 11) | 20) & 0xFu; }
#define XB_SPIN(cond, bar) do { unsigned _sp = 0; while (cond) { __builtin_amdgcn_s_sleep(1); \
    if ((++_sp & 255u) == 0u) { if (xb_ld(&(bar)[XB_TMO])) break; if (_sp > XB_SPIN_CAP) { atomicAdd(&(bar)[XB_TMO], 1u); break; } } } } while (0)
struct XcdBarrier { unsigned* bar; unsigned x; volatile LAS unsigned* st; };
DI XcdBarrier xcd_barrier_post(unsigned* bar, volatile LAS unsigned* st) {
    XcdBarrier b; b.bar = bar; b.x = xb_xcc_id(); b.st = st;
    if (threadIdx.x == 0) (void)xb_add(&bar[XB_XCNT(b.x)], 1u);
    return b;
}
DI void xcd_barrier_complete(unsigned* bar, unsigned x, unsigned& nloc, unsigned& nx) {
    const unsigned G = gridDim.x * gridDim.y * gridDim.z;
    unsigned sum, cnt, mine, sp = 0u;
    for (;;) {
        sum = 0u; cnt = 0u; mine = 0u;
#pragma unroll
        for (unsigned j = 0; j < 16; ++j) { const unsigned c = xb_ld(&bar[XB_XCNT(j)]); sum += c; cnt += (c > 0u) ? 1u : 0u; mine = (j == x) ? c : mine; }
        if (sum == G) break;
        __builtin_amdgcn_s_sleep(1);
        if ((++sp & 255u) == 0u) { if (xb_ld(&bar[XB_TMO])) break; if (sp > XB_SPIN_CAP) { atomicAdd(&bar[XB_TMO], 1u); break; } }
    }
    nloc = mine > 0u ? mine : 1u; nx = cnt > 0u ? cnt : 1u;
}
DI void xcd_barrier(const XcdBarrier& b) {
    asm volatile("s_waitcnt vmcnt(0)" ::: "memory");
    __syncthreads();
    if (threadIdx.x == 0) {
        const unsigned long long ba = (unsigned long long)b.bar;
        unsigned blo = (unsigned)__builtin_amdgcn_readfirstlane((int)(unsigned)ba), bhi = (unsigned)__builtin_amdgcn_readfirstlane((int)(unsigned)(ba >> 32));
        asm volatile("" : "+s"(blo), "+s"(bhi));
        unsigned* bar = (unsigned*)(((unsigned long long)bhi << 32) | blo);
        const unsigned bx = (unsigned)__builtin_amdgcn_readfirstlane((int)b.x);
        __builtin_amdgcn_s_waitcnt(0);
        unsigned nloc = b.st[0], nx = b.st[1];
        if (nloc == 0u) { xcd_barrier_complete(bar, bx, nloc, nx); b.st[0] = nloc; b.st[1] = nx; }
        const unsigned old = xb_add(&bar[XB_XSUB(bx)], 1u);
        const unsigned gen = old / nloc;
        if (old + 1u == (gen + 1u) * nloc) {
            __builtin_amdgcn_fence(__ATOMIC_RELEASE, "agent");
            asm volatile("s_waitcnt vmcnt(0)" ::: "memory");
            const unsigned og = xb_add(&bar[XB_TOP], 1u);
            const unsigned tg = og / nx;
            if (og + 1u == (tg + 1u) * nx) xb_add(&bar[XB_TOPGEN], 1u);
            else XB_SPIN(xb_ld(&bar[XB_TOPGEN]) == tg, bar);
            __builtin_amdgcn_fence(__ATOMIC_ACQUIRE, "agent");
            xb_add(&bar[XB_XGEN(bx)], 1u);
            asm volatile("s_waitcnt vmcnt(0)" ::: "memory");
        } else {
            XB_SPIN(xb_ld(&bar[XB_XGEN(bx)]) == gen, bar);
            __builtin_amdgcn_fence(__ATOMIC_ACQUIRE, "agent");
            asm volatile("s_waitcnt vmcnt(0)" ::: "memory");
        }
    }
    __syncthreads();
}

namespace pg8 {
constexpr int BM = 256, BK = 64, HALF = 128, HTB = HALF * BK * 2, STAGE_BYTES = 8 * HTB, NXCD = 8, WGM = 8;
DI int lds_byte(int r, int c) { const int st = (r >> 4) * 2 + (c >> 5), rr = r & 15, cc = c & 31, ob = rr * 64 + cc * 2; return st * 1024 + (ob ^ (((ob >> 9) & 1) << 5)); }
DI void stage_rc(int b, int& R, int& C) { const int st = b / 1024, sb = b % 1024, swz = sb ^ (((sb >> 9) & 1) << 5); R = (st >> 1) * 16 + swz / 64; C = (st & 1) * 32 + (swz % 64) / 2; }
DI int perm32(int rho) { const int n = rho >> 4, i = rho & 15; return 8 * (i >> 2) + 4 * n + (i & 3); }
struct Unit { int pm, pn; };
struct Gemm { const bf16_t* A; const bf16_t* Bt; int lda, ldb; int M, N, K; };
struct StaticOrder {
    int nM, nN, nwg, G, c;
    DI void init(int M, int N, int G_, int c_) { nM = M / BM; nN = N / BM; nwg = nM * nN; G = G_; c = c_; }
    DI bool next(int i, Unit& u) const {
        const long L = (long)i * G + c; if (L >= nwg) return false;
        int wgid = (int)L; { const int q = nwg / NXCD, r = nwg % NXCD, xcd = wgid % NXCD, off = wgid / NXCD; wgid = (xcd < r ? xcd * (q + 1) : r * (q + 1) + (xcd - r) * q) + off; }
        const int nig = WGM * nN, gid = wgid / nig, fm = gid * WGM, gsz = (nM - fm) < WGM ? (nM - fm) : WGM;
        u.pm = fm + ((wgid % nig) % gsz); u.pn = (wgid % nig) / gsz; return true;
    }
};

template <class Epi>
DI void gemm_phase(LAS unsigned char* lds, const Gemm g, const StaticOrder& S, const Epi& E) {
    const int tid = otid(), wid = __builtin_amdgcn_readfirstlane(tid >> 6), lane = tid & 63, wr = wid >> 2, wc = wid & 3, fr = lane & 15, fq = lane >> 4;
    const int K = g.K, nt = K / BK;
    unsigned voffA[2], voffB[2];
#pragma unroll
    for (int i = 0; i < 2; ++i) { int R, C; stage_rc(tid * 16 + i * 8192, R, C); const int Rb = Epi::PERM ? ((R & ~31) + perm32(R & 31)) : R;
        voffA[i] = (unsigned)(R * g.lda + C) * 2u; voffB[i] = (unsigned)(Rb * g.ldb + C) * 2u; }
    const size_t kstep = (size_t)(BK * 2);
    const size_t hstepA = (size_t)HALF * g.lda * 2, hstepB = (size_t)HALF * g.ldb * 2;
    const size_t tstepA = 2 * hstepA, tstepB = 2 * hstepB;
    const unsigned ldsw = (unsigned)wid * 1024u;
    const int aoff = lds_byte(wr * 64 + fr, fq * 8), boff = lds_byte(wc * 32 + fr, fq * 8);
#define PG8_SA(b, h) (((b) * 2 + (h)) * HTB)
#define PG8_SB(b, h) ((4 + (b) * 2 + (h)) * HTB)
#define PG8_STAGE(bufoff, gbase, voff) do { _Pragma("unroll") for (int _i = 0; _i < 2; ++_i) \
        __builtin_amdgcn_global_load_lds((const unsigned*)((const char*)(gbase) + (voff)[_i]), (LAS unsigned*)(lds + (bufoff) + ldsw + _i * 8192), 16, 0, 0); } while (0)
#define PG8_LDA(dst, b, h) do { _Pragma("unroll") for (int m = 0; m < 4; ++m) _Pragma("unroll") for (int k = 0; k < 2; ++k) dst[m][k] = *(const LAS bf16x8*)(lds + PG8_SA(b, h) + aoff + m * 2048 + k * 1024); } while (0)
#define PG8_LDB(dst, b, h) do { _Pragma("unroll") for (int n = 0; n < 2; ++n) _Pragma("unroll") for (int k = 0; k < 2; ++k) dst[n][k] = *(const LAS bf16x8*)(lds + PG8_SB(b, h) + boff + n * 2048 + k * 1024); } while (0)
#define PG8_MMA(ai, bj, At, Bt) do { __builtin_amdgcn_s_setprio(1); _Pragma("unroll") for (int m = 0; m < 4; ++m) _Pragma("unroll") for (int n = 0; n < 2; ++n) _Pragma("unroll") for (int k = 0; k < 2; ++k) \
        acc[ai][bj][m][n] = __builtin_amdgcn_mfma_f32_16x16x32_bf16(Bt[n][k], At[m][k], acc[ai][bj][m][n], 0, 0, 0); __builtin_amdgcn_s_setprio(0); } while (0)
#define PG8_WAIT_V(n) asm volatile("s_waitcnt vmcnt(" #n ")" ::: "memory")
#define PG8_WAIT_L(n) asm volatile("s_waitcnt lgkmcnt(" #n ")" ::: "memory")
#define PG8_BAR __builtin_amdgcn_s_barrier()
#define PG8_SCHED __builtin_amdgcn_sched_barrier(0)
    Unit cur, nxt; int ui = 0;
    if (!S.next(0, cur)) return;
    f32x4 acc[2][2][4][2];
#pragma unroll
    for (int a = 0; a < 2; ++a)
#pragma unroll
        for (int b = 0; b < 2; ++b)
#pragma unroll
            for (int m = 0; m < 4; ++m)
#pragma unroll
                for (int n = 0; n < 2; ++n) acc[a][b][m][n] = (f32x4){0.f, 0.f, 0.f, 0.f};
    bf16x8 At[4][2], B0[2][2], B1[2][2];
    const char* cA = (const char*)g.A + (size_t)cur.pm * tstepA; const char* cB = (const char*)g.Bt + (size_t)cur.pn * tstepB;
    PG8_STAGE(PG8_SB(0, 0), cB, voffB); PG8_STAGE(PG8_SA(0, 0), cA, voffA); PG8_STAGE(PG8_SB(0, 1), cB + hstepB, voffB); PG8_STAGE(PG8_SA(0, 1), cA + hstepA, voffA);
    if (wr == 1) PG8_BAR;
    PG8_WAIT_V(4); PG8_BAR;
    PG8_STAGE(PG8_SB(1, 0), cB + kstep, voffB); PG8_STAGE(PG8_SA(1, 0), cA + kstep, voffA); PG8_STAGE(PG8_SB(1, 1), cB + hstepB + kstep, voffB);
    PG8_WAIT_V(6); PG8_BAR;
    for (;;) {
        const bool has_next = S.next(ui + 1, nxt);
        const char* nA = has_next ? (const char*)g.A + (size_t)nxt.pm * tstepA : cA; const char* nB = has_next ? (const char*)g.Bt + (size_t)nxt.pn * tstepB : cB;
        for (int t = 0; t < nt; t += 2) {
            const bool last = (t == nt - 2);
            const char* a1 = cA + (size_t)(t + 1) * kstep;
            const char* a2 = last ? nA : cA + (size_t)(t + 2) * kstep; const char* b2 = last ? nB : cB + (size_t)(t + 2) * kstep;
            const char* a3 = a2 + kstep; const char* b3 = b2 + kstep;
            PG8_LDB(B0, 0, 0); PG8_SCHED; PG8_LDA(At, 0, 0); PG8_STAGE(PG8_SA(1, 1), a1 + hstepA, voffA);
            PG8_WAIT_L(8); PG8_BAR; PG8_WAIT_L(0); PG8_MMA(0, 0, At, B0); PG8_BAR; PG8_SCHED;
            PG8_LDB(B1, 0, 1); PG8_STAGE(PG8_SB(0, 0), b2, voffB);
            PG8_BAR; PG8_WAIT_L(0); PG8_MMA(0, 1, At, B1); PG8_BAR;
            PG8_LDA(At, 0, 1); PG8_STAGE(PG8_SA(0, 0), a2, voffA);
            PG8_BAR; PG8_WAIT_L(0); PG8_MMA(1, 0, At, B0); PG8_BAR; PG8_SCHED;
            PG8_STAGE(PG8_SB(0, 1), b2 + hstepB, voffB);
            PG8_WAIT_V(6); PG8_BAR; PG8_MMA(1, 1, At, B1); PG8_BAR;
            PG8_LDB(B0, 1, 0); PG8_SCHED; PG8_LDA(At, 1, 0); PG8_STAGE(PG8_SA(0, 1), a2 + hstepA, voffA);
            PG8_WAIT_L(8); PG8_BAR; PG8_WAIT_L(0); PG8_MMA(0, 0, At, B0); PG8_BAR; PG8_SCHED;
            PG8_LDB(B1, 1, 1); PG8_STAGE(PG8_SB(1, 0), b3, voffB);
            PG8_BAR; PG8_WAIT_L(0); PG8_MMA(0, 1, At, B1); PG8_BAR;
            PG8_LDA(At, 1, 1); PG8_STAGE(PG8_SA(1, 0), a3, voffA);
            PG8_BAR; PG8_WAIT_L(0); PG8_MMA(1, 0, At, B0); PG8_BAR; PG8_SCHED;
            PG8_STAGE(PG8_SB(1, 1), b3 + hstepB, voffB);
            PG8_WAIT_V(6); PG8_BAR; PG8_MMA(1, 1, At, B1); PG8_BAR;
        }
        E(acc, cur, wr, wc, fr, fq);
        if (!has_next) break;
#pragma unroll
        for (int a = 0; a < 2; ++a)
#pragma unroll
            for (int b = 0; b < 2; ++b)
#pragma unroll
                for (int m = 0; m < 4; ++m)
#pragma unroll
                    for (int n = 0; n < 2; ++n) acc[a][b][m][n] = (f32x4){0.f, 0.f, 0.f, 0.f};
        cur = nxt; cA = nA; cB = nB; ++ui;
    }
    PG8_WAIT_V(0);
    if (wr == 0) PG8_BAR;
    PG8_BAR;
#undef PG8_SA
#undef PG8_SB
#undef PG8_STAGE
#undef PG8_LDA
#undef PG8_LDB
#undef PG8_MMA
#undef PG8_WAIT_V
#undef PG8_WAIT_L
#undef PG8_BAR
#undef PG8_SCHED
}

struct EpiSwiglu {
    static constexpr bool PERM = true;
    bf16_t* H; int ldh;
    DI void operator()(const f32x4 (&acc)[2][2][4][2], const Unit& u, int wr, int wc, int fr, int fq) const {
        const int row0 = u.pm * BM + wr * 64 + fr, col0 = u.pn * HALF + wc * 32 + 8 * fq;
#pragma unroll
        for (int ai = 0; ai < 2; ++ai)
#pragma unroll
            for (int m = 0; m < 4; ++m) {
                bf16_t* rowp = H + (size_t)(row0 + ai * HALF + m * 16) * ldh + col0;
                const f32x4 g0 = acc[ai][0][m][0], g1 = acc[ai][0][m][1], u0 = acc[ai][1][m][0], u1 = acc[ai][1][m][1];
                u32x4 w;
                w.x = pk2(silu_f(g0[0]) * u0[0], silu_f(g0[1]) * u0[1]); w.y = pk2(silu_f(g0[2]) * u0[2], silu_f(g0[3]) * u0[3]);
                w.z = pk2(silu_f(g1[0]) * u1[0], silu_f(g1[1]) * u1[1]); w.w = pk2(silu_f(g1[2]) * u1[2], silu_f(g1[3]) * u1[3]);
                *(u32x4*)rowp = w;
            }
    }
};
struct EpiGlu {
    static constexpr bool PERM = true;
    bf16_t* O; int ldo; int col_base; const float* bias;
    DI void operator()(const f32x4 (&acc)[2][2][4][2], const Unit& u, int wr, int wc, int fr, int fq) const {
        const int row0 = u.pm * BM + wr * 64 + fr, c0 = u.pn * HALF + wc * 32 + 8 * fq;
#pragma unroll
        for (int ai = 0; ai < 2; ++ai)
#pragma unroll
            for (int m = 0; m < 4; ++m) {
                const f32x4 ba0 = *(const volatile f32x4*)(bias + c0), ba1 = *(const volatile f32x4*)(bias + c0 + 4), bg0 = *(const volatile f32x4*)(bias + 256 + c0), bg1 = *(const volatile f32x4*)(bias + 256 + c0 + 4);
                bf16_t* rowp = O + (size_t)(row0 + ai * HALF + m * 16) * ldo + col_base + c0;
                const f32x4 a0 = acc[ai][0][m][0] + ba0, a1 = acc[ai][0][m][1] + ba1, g0 = acc[ai][1][m][0] + bg0, g1 = acc[ai][1][m][1] + bg1;
                u32x4 w;
                w.x = pk2(a0[0] * sigmoid_f(g0[0]), a0[1] * sigmoid_f(g0[1])); w.y = pk2(a0[2] * sigmoid_f(g0[2]), a0[3] * sigmoid_f(g0[3]));
                w.z = pk2(a1[0] * sigmoid_f(g1[0]), a1[1] * sigmoid_f(g1[1])); w.w = pk2(a1[2] * sigmoid_f(g1[2]), a1[3] * sigmoid_f(g1[3]));
                *(u32x4*)rowp = w;
            }
    }
};
struct EpiResid {
    static constexpr bool PERM = false;
    const float* rin_x; const float* rin_c; float* rout_x; float* rout_c; const float* gate; float gs;
    DI void operator()(const f32x4 (&acc)[2][2][4][2], const Unit& u, int wr, int wc, int fr, int fq) const {
        const int trow = u.pm * BM; const bool isx = trow < TX;
        const int mb = isx ? (trow >> 11) : 8;
        const float* rin = isx ? rin_x + (size_t)trow * DM : rin_c + (size_t)(trow - TX) * DM;
        float* rout = isx ? rout_x + (size_t)trow * DM : rout_c + (size_t)(trow - TX) * DM;
        const int r0 = wr * 64 + fr, col0 = u.pn * BM + wc * 32 + 4 * fq;
        f32x4 gv[2][2];
#pragma unroll
        for (int bj = 0; bj < 2; ++bj)
#pragma unroll
            for (int n = 0; n < 2; ++n) gv[bj][n] = *(const f32x4*)(gate + (size_t)mb * 9216 + col0 + bj * HALF + n * 16) * gs;
#pragma unroll
        for (int ai = 0; ai < 2; ++ai)
#pragma unroll
            for (int m = 0; m < 4; ++m) {
                const size_t ro = (size_t)(r0 + ai * HALF + m * 16) * DM + col0;
#pragma unroll
                for (int bj = 0; bj < 2; ++bj)
#pragma unroll
                    for (int n = 0; n < 2; ++n) {
                        const f32x4 r = *(const f32x4*)(rin + ro + bj * HALF + n * 16);
                        *(f32x4*)(rout + ro + bj * HALF + n * 16) = r + gv[bj][n] * acc[ai][bj][m][n];
                    }
            }
    }
};
struct EpiResidAtomicC {
    static constexpr bool PERM = false;
    float* rout_c; const float* gate; float gs;
    DI void operator()(const f32x4 (&acc)[2][2][4][2], const Unit& u, int wr, int wc, int fr, int fq) const {
        float* rout = rout_c + (size_t)u.pm * BM * DM;
        const int r0 = wr * 64 + fr, col0 = u.pn * BM + wc * 32 + 4 * fq;
#pragma unroll
        for (int bj = 0; bj < 2; ++bj)
#pragma unroll
            for (int n = 0; n < 2; ++n) {
                const f32x4 gv = *(const f32x4*)(gate + (size_t)8 * 9216 + col0 + bj * HALF + n * 16) * gs;
#pragma unroll
                for (int ai = 0; ai < 2; ++ai)
#pragma unroll
                    for (int m = 0; m < 4; ++m) *(f32x4*)(rout + (size_t)(r0 + ai * HALF + m * 16) * DM + col0 + bj * HALF + n * 16) = gv * acc[ai][bj][m][n];
            }
    }
};
struct EpiStore {
    static constexpr bool PERM = true;
    bf16_t* O; int ldo; int rows_valid; int cols_valid; int kmap;
    DI void operator()(const f32x4 (&acc)[2][2][4][2], const Unit& u, int wr, int wc, int fr, int fq) const {
        const int row0 = u.pm * BM + wr * 64 + fr;
#pragma unroll
        for (int bj = 0; bj < 2; ++bj) {
            const int c = u.pn * BM + bj * HALF + wc * 32 + 8 * fq;
            if (c >= cols_valid) continue;
            const int cd = kmap ? (96 * (c >> 6) + (c & 63)) : c;
#pragma unroll
            for (int ai = 0; ai < 2; ++ai)
#pragma unroll
                for (int m = 0; m < 4; ++m) {
                    const int row = row0 + ai * HALF + m * 16;
                    if (row < rows_valid) {
                        const f32x4 v0 = acc[ai][bj][m][0], v1 = acc[ai][bj][m][1];
                        u32x4 w; w.x = pk2(v0[0], v0[1]); w.y = pk2(v0[2], v0[3]); w.z = pk2(v1[0], v1[1]); w.w = pk2(v1[2], v1[3]);
                        *(u32x4*)(O + (size_t)row * ldo + cd) = w;
                    }
                }
        }
    }
};
}

template <class Epi>
DI void gemm_call(LAS unsigned char* lds, const bf16_t* A, int lda, const bf16_t* Bt, int ldb, int M, int N, int K, const Epi& E, int coff) {
    pg8::Gemm g; g.A = A; g.Bt = Bt; g.lda = lda; g.ldb = ldb; g.M = M; g.N = N; g.K = K;
    pg8::StaticOrder S; S.init(M, N, (int)gridDim.x, (int)(((unsigned)obid() + (unsigned)coff) % gridDim.x));
    pg8::gemm_phase<Epi>(lds, g, S, E);
}


DI void transpose_item(const float* W, int K, int N, bf16_t* WT, int k0, int n0, int drow0, LAS float* scr, int lane) {
    f32x4 tv[8];
    const int kr = lane >> 3, n4 = (lane & 7) * 4;
#pragma unroll
    for (int i = 0; i < 8; ++i) tv[i] = *(const f32x4*)(W + (size_t)(k0 + 8 * i + kr) * N + n0 + n4);
#pragma unroll
    for (int i = 0; i < 8; ++i) { LAS float* d = scr + (8 * i + kr) * 33 + n4; d[0] = tv[i][0]; d[1] = tv[i][1]; d[2] = tv[i][2]; d[3] = tv[i][3]; }
    LDS_WAIT();
    const int c = lane & 7;
#pragma unroll
    for (int j = 0; j < 4; ++j) {
        const int n = (lane >> 3) + 8 * j; const LAS float* sp = scr + (8 * c) * 33 + n;
        u32x4 o; o.x = pk2(sp[0 * 33], sp[1 * 33]); o.y = pk2(sp[2 * 33], sp[3 * 33]); o.z = pk2(sp[4 * 33], sp[5 * 33]); o.w = pk2(sp[6 * 33], sp[7 * 33]);
        *(u32x4*)(WT + (size_t)(drow0 + n) * K + k0 + 8 * c) = o;
    }
    LDS_WAIT();
}
DI int gu_map(int n0, int half) { const int j = n0 < half ? n0 : n0 - half; return 256 * (j >> 7) + (n0 < half ? 0 : 128) + (j & 127); }
constexpr int I_GU = 2 * 16 * 176, I_DN = 2 * 44 * 32, I_IN = 16 * 65, I_OUT = 16 * 32, I_UQ = 6 * 18, I_UKV = 4 * 24, I_GLU = 4 * 16;
constexpr int I_L = I_GU + I_DN + I_IN + I_OUT + I_UQ + I_UKV + I_GLU;
constexpr int I_FIRST = 16 * 176;
DI void do_transposes(const Params& P, LAS unsigned char* lds, int first, int last, int widx, int nw) {
    const int tid_ = otid(); const int lane = tid_ & 63, wave = tid_ >> 6;
    unsigned char* ws = ows(P);
    LAS float* scr = (LAS float*)lds + wave * (64 * 33);
    for (int it = first + widx; it < last; it += nw) {
        const int l = it / I_L; int r = it % I_L;
        if (r < I_GU) { const int f = r / (16 * 176), q = r % (16 * 176), kb = q / 176, nb = q % 176, n0 = nb * 32;
            transpose_item(P.in[oidx(7)] + (size_t)(l * 2 + f) * 1024 * 5632, 1024, 5632, (bf16_t*)(ws + OFF_WGU) + (size_t)(l * 2 + f) * 5632 * 1024, kb * 64, n0, gu_map(n0, 2816), scr, lane); continue; }
        r -= I_GU;
        if (r < I_DN) { const int f = r / (44 * 32), q = r % (44 * 32), kb = q / 32, nb = q % 32;
            transpose_item(P.in[oidx(8)] + (size_t)(l * 2 + f) * 2816 * 1024, 2816, 1024, (bf16_t*)(ws + OFF_WDN) + (size_t)(l * 2 + f) * 1024 * 2816, kb * 64, nb * 32, nb * 32, scr, lane); continue; }
        r -= I_DN;
        if (r < I_IN) { const int kb = r / 65, nb = r % 65, n0 = nb * 32;
            bf16_t* dst; int drow;
            if (n0 < 768) { dst = (bf16_t*)(ws + OFF_WIN) + (size_t)l * NZ * 1024; drow = n0; }
            else if (n0 < 1152) { dst = (bf16_t*)(ws + OFF_WVA) + (size_t)l * 512 * 1024; drow = n0 - 768; }
            else { dst = (bf16_t*)(ws + OFF_WIN) + (size_t)l * NZ * 1024; drow = n0 - 384; }
            transpose_item(P.in[oidx(9)] + (size_t)l * 1024 * 2080, 1024, 2080, dst, kb * 64, n0, drow, scr, lane); continue; }
        r -= I_IN;
        if (r < I_OUT) { const int kb = r / 32, nb = r % 32;
            transpose_item(P.in[oidx(10)] + (size_t)l * 1024 * 1024, 1024, 1024, (bf16_t*)(ws + OFF_WOUT) + (size_t)l * 1024 * 1024, kb * 64, nb * 32, nb * 32, scr, lane); continue; }
        r -= I_OUT;
        if (r < I_UQ) { const int kb = r / 18, nb = r % 18;
            transpose_item(P.in[oidx(15)] + (size_t)l * 384 * 576, 384, 576, (bf16_t*)(ws + OFF_WUQ) + (size_t)l * 768 * 384, kb * 64, nb * 32, nb * 32, scr, lane); continue; }
        r -= I_UQ;
        if (r < I_UKV) { const int kb = r / 24, nb = r % 24, n0 = nb * 32, h = n0 >> 7, j = n0 & 127;
            bf16_t* dst = (j < 64) ? (bf16_t*)(ws + OFF_WUK) + (size_t)l * 512 * 256 : (bf16_t*)(ws + OFF_WUV) + (size_t)l * 512 * 256;
            transpose_item(P.in[oidx(16)] + (size_t)l * 256 * 768, 256, 768, dst, kb * 64, n0, 64 * h + (j & 63), scr, lane); continue; }
        r -= I_UKV;
        { const int kb = r / 16, nb = r % 16, n0 = nb * 32;
            transpose_item(P.in[oidx(26)] + (size_t)l * 256 * 512, 256, 512, (bf16_t*)(ws + OFF_WGLU) + (size_t)l * 512 * 256, kb * 64, n0, gu_map(n0, 256), scr, lane); }
    }
}

DI void deferred_transposes(const Params& P, LAS unsigned char* lds, int slot, int first_idle) {
    const int c = obid(); if (c < first_idle || slot > 3) return;
    const int nw = (256 - first_idle) * 8, widx = (c - first_idle) * 8 + (otid() >> 6);
    if (slot == 0) { do_transposes(P, lds, 5632, 7040, widx, nw); do_transposes(P, lds, 8448, I_L, widx, nw); }
    else if (slot == 1) { do_transposes(P, lds, 2816, 5632, widx, nw); do_transposes(P, lds, 7040, 8448, widx, nw); }
    else if (slot == 2) { do_transposes(P, lds, I_L + 0, I_L + 2816, widx, nw); do_transposes(P, lds, I_L + 5632, I_L + 7040, widx, nw); do_transposes(P, lds, I_L + 8448, 2 * I_L, widx, nw); }
    else { do_transposes(P, lds, I_L + 2816, I_L + 5632, widx, nw); do_transposes(P, lds, I_L + 7040, I_L + 8448, widx, nw); }
}
DI void s5_tables(const Params& P, int ldg, LAS unsigned char* lds, int tid);
DI void phase_prep(const Params& P, LAS unsigned char* lds) {
    const int tid = otid(), lane = tid & 63, wave = tid >> 6, G = gridDim.x, bid = obid();
    unsigned char* ws = ows(P);
    if (bid == 0 && tid < 64) ((unsigned*)(ws + OFF_CTR))[tid] = 0u;
    {
        LAS float* sv = (LAS float*)lds; LAS float* red = sv + 9 * 1024;
        for (int i = tid; i < 9 * 1024; i += 512) { const int mb = i >> 10, k = i & 1023; const float c = mb < 8 ? P.in[oidx(1)][mb * 1024 + k] : P.in[oidx(3)][k]; sv[i] = c / (1.f + expf(-c)); }
        __syncthreads();
        float* mods = (float*)(ws + OFF_MODS);
        for (int u = bid; u < 288; u += G) {
            const int l = u / 144, cgp = u % 144, kq = lane >> 4, c4 = (lane & 15) * 4;
            const float* W = P.in[oidx(4)] + (size_t)l * 1024 * 9216 + cgp * 64 + c4;
            f32x4 a[9];
#pragma unroll
            for (int mb = 0; mb < 9; ++mb) a[mb] = (f32x4){0.f, 0.f, 0.f, 0.f};
            for (int i0 = 0; i0 < 32; i0 += 8) {
                f32x4 w8[8];
#pragma unroll
                for (int i = 0; i < 8; ++i) w8[i] = *(const f32x4*)(W + (size_t)(wave * 128 + 4 * (i0 + i) + kq) * 9216);
#pragma unroll
                for (int i = 0; i < 8; ++i) { const int k = wave * 128 + 4 * (i0 + i) + kq;
#pragma unroll
                    for (int mb = 0; mb < 9; ++mb) a[mb] += w8[i] * sv[mb * 1024 + k]; }
            }
#pragma unroll
            for (int mb = 0; mb < 9; ++mb) *(LAS f32x4*)(red + ((wave * 4 + kq) * 9 + mb) * 64 + c4) = a[mb];
            __syncthreads();
            for (int i = tid; i < 576; i += 512) {
                const int mb = i >> 6, cc = i & 63; float sum = 0.f;
#pragma unroll
                for (int k32 = 0; k32 < 32; ++k32) sum += red[(k32 * 9 + mb) * 64 + cc];
                mods[(size_t)(l * 9 + mb) * 9216 + cgp * 64 + cc] = sum + P.in[oidx(5)][l * 9216 + cgp * 64 + cc];
            }
            __syncthreads();
        }
        __syncthreads();
    }
    { const f32x4* src = (const f32x4*)P.in[oidx(2)]; f32x4* dst = (f32x4*)(ws + OFF_HXC); for (int i = bid * 512 + tid; i < TC * DM / 4; i += G * 512) dst[i] = src[i]; }
    const int gtid = bid * 512 + tid, GT = G * 512;
    if (gtid < 512) { const int pos = gtid >> 3, i = gtid & 7; const float inv = exp2f(-(float)i * 0.125f * 13.287712379549449f); const float ang = (float)pos * inv;
        float* rt = (float*)(ws + OFF_ROPE); rt[gtid * 2] = cosf(ang); rt[gtid * 2 + 1] = sinf(ang); }
    for (int it = (bid + G - 64) % G; it < 64; it += G) s5_tables(P, it, lds, tid);
    __syncthreads();
    do_transposes(P, lds, 0, gridDim.x == 256 ? I_FIRST : 2 * I_L, bid * 8 + wave, G * 8);
}

DI void phase_modulate(const float* src_x, float* src_c, int nrows, const float* g, const float* shift, const float* scale, bf16_t* A, const float* slab) {
    const int tid_ = otid(); const int lane = tid_ & 63, gw = obid() * 8 + (tid_ >> 6), NGW = gridDim.x * 8;
    for (int row = gw; row < nrows; row += NGW) {
        const float* xr = row < TX ? src_x + (size_t)row * DM : src_c + (size_t)(row - TX) * DM;
        const int mb = row < TX ? (row >> 11) : 8;
        f32x4 v[4]; float ss = 0.f;
#pragma unroll
        for (int j = 0; j < 4; ++j) v[j] = *(const f32x4*)(xr + 4 * lane + 256 * j);
        if (slab != nullptr && row >= TX) {
            const float* s0 = slab + (size_t)(row - TX) * DM; float* hw = src_c + (size_t)(row - TX) * DM;
#pragma unroll
            for (int j = 0; j < 4; ++j) { v[j] += (*(const f32x4*)(s0 + 4 * lane + 256 * j) + *(const f32x4*)(s0 + (size_t)TC * DM + 4 * lane + 256 * j))
                                              + (*(const f32x4*)(s0 + (size_t)2 * TC * DM + 4 * lane + 256 * j) + *(const f32x4*)(s0 + (size_t)3 * TC * DM + 4 * lane + 256 * j)); *(f32x4*)(hw + 4 * lane + 256 * j) = v[j]; }
        }
#pragma unroll
        for (int j = 0; j < 4; ++j) ss += v[j].x * v[j].x + v[j].y * v[j].y + v[j].z * v[j].z + v[j].w * v[j].w;
        const float r = 1.f / sqrtf(wave_sum(ss, lane) * (1.f / DM) + EPSN);
#pragma unroll
        for (int j = 0; j < 4; ++j) {
            const int c = 4 * lane + 256 * j;
            const f32x4 gg = *(const f32x4*)(g + c), sh = *(const f32x4*)(shift + (size_t)mb * 9216 + c), sc = *(const f32x4*)(scale + (size_t)mb * 9216 + c);
            const f32x4 y = v[j] * r * gg * (sc + 1.f) + sh;
            u32x2 w; w.x = pk2(y.x, y.y); w.y = pk2(y.z, y.w);
            *(u32x2*)(A + (size_t)row * DM + c) = w;
        }
    }
}

DI void phase_znorm(const Params& P, int l) {
    const int tid_ = otid(); const int lane = tid_ & 63, gw = obid() * 8 + (tid_ >> 6), NGW = gridDim.x * 8;
    bf16_t* z = (bf16_t*)(ows(P) + OFF_Z);
    const float* gq = P.in[oidx(11)] + l * 128; const float* gk = gq + 64;
    const float* gcq = P.in[oidx(13)] + l * 384; const float* gckv = P.in[oidx(14)] + l * 256;
    const float qs = 0.125f * LOG2E;
    for (int row = gw; row < TT; row += NGW) {
        bf16_t* zr = z + (size_t)row * NZ;
        const bool a48 = lane < 48, a32 = lane < 32;
        u32x4 wq = {0, 0, 0, 0}, wk = {0, 0, 0, 0}, wc = {0, 0, 0, 0}, wv = {0, 0, 0, 0};
        if (a48) { wq = *(const u32x4*)(zr + ZQA + 8 * lane); wk = *(const u32x4*)(zr + ZKA + 8 * lane); wc = *(const u32x4*)(zr + ZCQ + 8 * lane); }
        if (a32) wv = *(const u32x4*)(zr + ZCKV + 8 * lane);
        float fq[8], fk[8], fc[8], fv[8]; unpack8(wq, fq); unpack8(wk, fk); unpack8(wc, fc); unpack8(wv, fv);
        float sq = 0, sk = 0, sc = 0, sv = 0;
#pragma unroll
        for (int i = 0; i < 8; ++i) { sq += fq[i] * fq[i]; sk += fk[i] * fk[i]; sc += fc[i] * fc[i]; sv += fv[i] * fv[i]; }
#pragma unroll
        for (int o = 1; o < 8; o <<= 1) { sq += shx(sq, o, lane); sk += shx(sk, o, lane); }
        sc = wave_sum(sc, lane); sv = wave_sum(sv, lane);
        const float rq = qs / sqrtf(sq * (1.f / 64.f) + EPSN), rk = 1.f / sqrtf(sk * (1.f / 64.f) + EPSN);
        const float rc = 1.f / sqrtf(sc * (1.f / 384.f) + EPSN), rv = 1.f / sqrtf(sv * (1.f / 256.f) + EPSN);
        const int hc = (8 * lane) & 63;
        if (a48) {
#pragma unroll
            for (int i = 0; i < 8; ++i) { fq[i] *= rq * gq[hc + i]; fk[i] *= rk * gk[hc + i]; fc[i] *= rc * gcq[8 * lane + i]; }
            *(u32x4*)(zr + ZQA + 8 * lane) = pack8(fq); *(u32x4*)(zr + ZKA + 8 * lane) = pack8(fk); *(u32x4*)(zr + ZCQ + 8 * lane) = pack8(fc);
        }
        if (a32) {
#pragma unroll
            for (int i = 0; i < 8; ++i) fv[i] *= rv * gckv[8 * lane + i];
            *(u32x4*)(zr + ZCKV + 8 * lane) = pack8(fv);
        }
    }
}

DI void phase_finish(const Params& P, int l) {
    const int tid_ = otid(); const int lane = tid_ & 63, gw = obid() * 8 + (tid_ >> 6), NGW = gridDim.x * 8;
    bf16_t* Qm = (bf16_t*)(ows(P) + OFF_QM); bf16_t* Km = (bf16_t*)(ows(P) + OFF_KM); const bf16_t* z = (const bf16_t*)(ows(P) + OFF_Z);
    const float* gq = P.in[oidx(17)] + l * 192; const float* gk = gq + 96;
    const float* rope = (const float*)(ows(P) + OFF_ROPE);
    const float qs = 0.10206207261596575f * LOG2E;
    const int hq = lane >> 4, ch = lane & 15;
    for (int row = gw; row < TT; row += NGW) {
        const bool lat = row < TX; const int n = row & 2047; const int pos = (ch < 10) ? (n >> 6) : (n & 63);
        const bool doq = lat || l == 0;
#pragma unroll
        for (int pass = 0; pass < 2; ++pass) {
            const int head = 4 * pass + hq; const bool act = (head < 6) && (ch < 12);
            u32x4 wq = {0, 0, 0, 0}, wk = {0, 0, 0, 0};
            if (act) {
                if (doq) wq = *(const u32x4*)(Qm + (size_t)row * 576 + head * 96 + 8 * ch);
                if (ch < 8) wk = *(const u32x4*)(Km + (size_t)row * 576 + head * 96 + 8 * ch);
                else wk = *(const u32x4*)(z + (size_t)row * NZ + ZKR + 8 * (ch - 8));
            }
            float fq[8], fk[8]; unpack8(wq, fq); unpack8(wk, fk);
            float sq = 0, sk = 0;
#pragma unroll
            for (int i = 0; i < 8; ++i) { sq += fq[i] * fq[i]; sk += fk[i] * fk[i]; }
#pragma unroll
            for (int o = 1; o < 16; o <<= 1) { sq += shx(sq, o, lane); sk += shx(sk, o, lane); }
            const float rq = 1.f / sqrtf(sq * (1.f / 96.f) + EPSN), rk = 1.f / sqrtf(sk * (1.f / 96.f) + EPSN);
            const int cch = ch < 12 ? ch : 0;
#pragma unroll
            for (int i = 0; i < 8; ++i) { fq[i] *= rq * gq[8 * cch + i]; fk[i] *= rk * gk[8 * cch + i]; }
#pragma unroll
            for (int i = 0; i < 8; ++i) {
                const float pq = shx(fq[i], 1, lane), pk = shx(fk[i], 1, lane);
                if (lat && ch >= 8 && ch < 12) {
                    const float c = rope[(pos * 8 + i) * 2], s = rope[(pos * 8 + i) * 2 + 1];
                    const float sg = (ch & 1) ? s : -s;
                    fq[i] = fq[i] * c + pq * sg; fk[i] = fk[i] * c + pk * sg;
                }
            }
            if (act) {
                if (doq) {
#pragma unroll
                    for (int i = 0; i < 8; ++i) fq[i] *= qs;
                    *(u32x4*)(Qm + (size_t)row * 576 + head * 96 + 8 * ch) = pack8(fq);
                }
                *(u32x4*)(Km + (size_t)row * 576 + head * 96 + 8 * ch) = pack8(fk);
            }
        }
    }
}

DI int s5_tok_row(int b, int cc, int s) { return cc < 16 ? TX + b * 256 + cc * 16 + s : b * 2048 + (cc - 16) * 16 + s; }
DI void s5_tables(const Params& P, int ldg, LAS unsigned char* lds, int tid) {
    LAS f32x2* pw = (LAS f32x2*)lds;
    LAS f32x2* bb = pw + 17 * 64;
    LAS f32x2* cc = bb + 64 * 16;
    LAS float* T = (LAS float*)(cc + 16 * 64);
    const int d = (ldg >> 4) & 1;
    unsigned char* ws = ows(P);
    if (tid < 64) {
        const int i = ldg * 64 + tid;
        const float lre = P.in[oidx(18)][i], lim = P.in[oidx(19)][i], dt = expf(P.in[oidx(20)][ldg]);
        const float er = expf(lre * dt), ang = lim * dt; const float lbr = er * cosf(ang), lbi = er * sinf(ang);
        const float nr = lbr - 1.f, ni = lbi, den = lre * lre + lim * lim;
        const float qr = (nr * lre + ni * lim) / den, qi = (ni * lre - nr * lim) / den;
        float wr = 1.f, wi = 0.f;
        for (int j = 0; j <= 16; ++j) { pw[j * 64 + tid] = (f32x2){wr, wi}; const float t = wr * lbr - wi * lbi; wi = wr * lbi + wi * lbr; wr = t; }
        ((f32x2*)(ws + OFF_S5L16))[i] = pw[16 * 64 + tid];
        for (int m = 0; m < 16; ++m) { const float br = P.in[oidx(21)][(size_t)i * 16 + m], bi = P.in[oidx(22)][(size_t)i * 16 + m]; bb[tid * 16 + m] = (f32x2){qr * br - qi * bi, qr * bi + qi * br}; }
    }
    for (int e = tid; e < 1024; e += 512) cc[e] = (f32x2){P.in[oidx(23)][(size_t)ldg * 1024 + e], P.in[oidx(24)][(size_t)ldg * 1024 + e]};
    __syncthreads();
    {
        const int m = (tid >> 4) & 15, mp = tid & 15, j0 = tid >> 8;
        float acc[8];
#pragma unroll
        for (int i = 0; i < 8; ++i) acc[i] = 0.f;
        for (int p = 0; p < 64; ++p) {
            const f32x2 c = cc[m * 64 + p], b = bb[p * 16 + mp];
            const float cbr = c.x * b.x - c.y * b.y, cbi = c.x * b.y + c.y * b.x;
#pragma unroll
            for (int i = 0; i < 8; ++i) { const f32x2 w = pw[(j0 + 2 * i) * 64 + p]; acc[i] += cbr * w.x - cbi * w.y; }
        }
#pragma unroll
        for (int i = 0; i < 8; ++i) T[((j0 + 2 * i) * 16 + m) * 16 + mp] = acc[i];
    }
    __syncthreads();
    bf16_t* Km = (bf16_t*)(ws + OFF_S5K) + (size_t)ldg * 65536;
    for (int ch = tid; ch < 8192; ch += 512) {
        const int row = ch >> 5, c0 = (ch & 31) * 8, t = row >> 4, m = row & 15, sx = c0 >> 4, mp0 = c0 & 15;
        const int lag = d == 0 ? t - sx : sx - t; float v[8];
#pragma unroll
        for (int i = 0; i < 8; ++i) v[i] = lag >= 0 ? T[(lag * 16 + m) * 16 + mp0 + i] : 0.f;
        *(u32x4*)(Km + (size_t)row * 256 + c0) = pack8(v);
    }
    bf16_t* Em = (bf16_t*)(ws + OFF_S5E) + (size_t)ldg * 32768;
    for (int ch = tid; ch < 4096; ch += 512) {
        const int row = ch >> 5, c0 = (ch & 31) * 8, p = row >> 1, c = row & 1, sx = c0 >> 4, mp0 = c0 & 15;
        const f32x2 w = pw[(d == 0 ? 15 - sx : sx) * 64 + p]; float v[8];
#pragma unroll
        for (int i = 0; i < 8; ++i) { const f32x2 b = bb[p * 16 + mp0 + i]; v[i] = c ? (w.x * b.y + w.y * b.x) : (w.x * b.x - w.y * b.y); }
        *(u32x4*)(Em + (size_t)row * 256 + c0) = pack8(v);
    }
    bf16_t* Fm = (bf16_t*)(ws + OFF_S5F) + (size_t)ldg * 32768;
    for (int ch = tid; ch < 4096; ch += 512) {
        const int row = ch >> 4, c0 = (ch & 15) * 8, t = row >> 4, m = row & 15, p0 = c0 >> 1; float v[8];
#pragma unroll
        for (int i = 0; i < 4; ++i) { const f32x2 w = pw[(d == 0 ? t + 1 : 16 - t) * 64 + p0 + i], c = cc[m * 64 + p0 + i];
            v[2 * i] = c.x * w.x - c.y * w.y; v[2 * i + 1] = -(c.x * w.y + c.y * w.x); }
        *(u32x4*)(Fm + (size_t)row * 128 + c0) = pack8(v);
    }
    __syncthreads();
}
DI void phase_s5_s1(const Params& P, int l) {
    const int tid_ = otid(); const int lane = tid_ & 63, fr = lane & 15, fq = lane >> 4, gw = (tid_ >> 6) * (int)gridDim.x + obid(), NGW = gridDim.x * 8;
    const bf16_t* z = (const bf16_t*)(ows(P) + OFF_Z);
    float* se = (float*)(ows(P) + OFF_SE);
    for (int it = gw; it < 2304; it += NGW) {
        const int cb = it % 72, gd = it / 72, d = gd & 1, g = gd >> 1, b = cb / 9, cc = 16 * (cb % 9) + fr;
        const bf16_t* Em = (const bf16_t*)(ows(P) + OFF_S5E) + (size_t)((l * 2 + d) * 16 + g) * 32768;
        bf16x8 uf[8];
#pragma unroll
        for (int ks = 0; ks < 8; ++ks) uf[ks] = *(const bf16x8*)(z + (size_t)s5_tok_row(b, cc, 2 * ks + (fq >> 1)) * NZ + ZU + 16 * g + 8 * (fq & 1));
        float* so = se + ((size_t)(((b * 16 + g) * 2 + d) * 144 + cc)) * 128 + 4 * fq;
#pragma unroll
        for (int rb = 0; rb < 8; ++rb) {
            bf16x8 a[8];
#pragma unroll
            for (int ks = 0; ks < 8; ++ks) a[ks] = *(const bf16x8*)(Em + (size_t)(rb * 16 + fr) * 256 + 32 * ks + 8 * fq);
            __builtin_amdgcn_sched_barrier(0);
            f32x4 acc = {0.f, 0.f, 0.f, 0.f};
#pragma unroll
            for (int ks = 0; ks < 8; ++ks) acc = __builtin_amdgcn_mfma_f32_16x16x32_bf16(a[ks], uf[ks], acc, 0, 0, 0);
            *(f32x4*)(so + 16 * rb) = acc;
            __builtin_amdgcn_sched_barrier(0);
        }
    }
}
DI void phase_s5_s2(const Params& P, int l, LAS unsigned char* lds) {
    const int tid_ = otid(); const int lane = tid_ & 63, wave = __builtin_amdgcn_readfirstlane(tid_ >> 6);
    const float* se = (const float*)(ows(P) + OFF_SE); bf16_t* hs = (bf16_t*)(ows(P) + OFF_SH);
    LAS f32x2* seg = (LAS f32x2*)lds;
    for (int line = obid(); line < 256; line += (int)gridDim.x) {
        const int d = line & 1, g = (line >> 1) & 15;
        const f32x2 lam = ((const f32x2*)(ows(P) + OFF_S5L16))[((l * 2 + d) * 16 + g) * 64 + lane];
        const float* sl = se + (size_t)line * 144 * 128 + 2 * lane; bf16_t* hl = hs + (size_t)line * 144 * 128 + 2 * lane;
        f32x2 ev[18];
#pragma unroll
        for (int i = 0; i < 18; ++i) { const int j = wave * 18 + i; const int cc = d == 0 ? j : (j < 16 ? 15 - j : 159 - j); ev[i] = *(const f32x2*)(sl + cc * 128); }
        float br = 0.f, bi = 0.f, ar = 1.f, ai = 0.f;
#pragma unroll
        for (int i = 0; i < 18; ++i) {
            const float nr = lam.x * br - lam.y * bi + ev[i].x, ni = lam.x * bi + lam.y * br + ev[i].y; br = nr; bi = ni;
            const float tr = lam.x * ar - lam.y * ai, ti = lam.x * ai + lam.y * ar; ar = tr; ai = ti;
        }
        seg[wave * 64 + lane] = (f32x2){br, bi};
        __syncthreads();
        float hr = 0.f, hi = 0.f;
        for (int sgi = 0; sgi < wave; ++sgi) { const f32x2 b2 = seg[sgi * 64 + lane]; const float nr = ar * hr - ai * hi + b2.x, ni = ar * hi + ai * hr + b2.y; hr = nr; hi = ni; }
#pragma unroll
        for (int i = 0; i < 18; ++i) {
            const int j = wave * 18 + i; const int cc = d == 0 ? j : (j < 16 ? 15 - j : 159 - j);
            *(unsigned*)(hl + cc * 128) = pk2(hr, hi);
            const float nr = lam.x * hr - lam.y * hi + ev[i].x, ni = lam.x * hi + lam.y * hr + ev[i].y; hr = nr; hi = ni;
        }
        __syncthreads();
    }
}
DI void phase_s5_s3(const Params& P, int l) {
    const int tid_ = otid(); const int lane = tid_ & 63, fr = lane & 15, fq = lane >> 4, gw = (tid_ >> 6) * (int)gridDim.x + obid(), NGW = gridDim.x * 8;
    const bf16_t* z = (const bf16_t*)(ows(P) + OFF_Z); const bf16_t* hs = (const bf16_t*)(ows(P) + OFF_SH); bf16_t* yb = (bf16_t*)(ows(P) + OFF_YB);
    for (int it = gw; it < 1152; it += NGW) {
        const int cbl = it % 9, b = (it / 9) & 7, g = it / 72;
        if (l == 1 && cbl == 0) continue;
        const int cc = 16 * cbl + fr;
        bf16x8 uf[8];
#pragma unroll
        for (int ks = 0; ks < 8; ++ks) uf[ks] = *(const bf16x8*)(z + (size_t)s5_tok_row(b, cc, 2 * ks + (fq >> 1)) * NZ + ZU + 16 * g + 8 * (fq & 1));
        f32x4 y[16];
#pragma unroll
        for (int t = 0; t < 16; ++t) y[t] = (f32x4){0.f, 0.f, 0.f, 0.f};
        const int ldg0 = (l * 2 + 0) * 16 + g;
        const bf16_t* Km0 = (const bf16_t*)(ows(P) + OFF_S5K) + (size_t)ldg0 * 65536 + (size_t)fr * 256 + 8 * fq;
        const bf16_t* Fm0 = (const bf16_t*)(ows(P) + OFF_S5F) + (size_t)ldg0 * 32768 + (size_t)fr * 128 + 8 * fq;
        const bf16_t* hp0 = hs + ((size_t)(((b * 16 + g) * 2 + 0) * 144 + cc)) * 128 + 8 * fq;
        bf16x8 hf[2][4];
#pragma unroll
        for (int d = 0; d < 2; ++d)
#pragma unroll
            for (int ks = 0; ks < 4; ++ks) hf[d][ks] = *(const bf16x8*)(hp0 + (size_t)d * 144 * 128 + 32 * ks);
#pragma unroll
        for (int t = 0; t < 16; ++t) {
            bf16x8 a[24]; int n = 0;
#pragma unroll
            for (int d = 0; d < 2; ++d) {
#pragma unroll
                for (int ks = 0; ks < 8; ++ks) if (d == 0 ? (2 * ks <= t) : (2 * ks + 1 >= t)) a[n++] = *(const bf16x8*)(Km0 + (size_t)d * 16 * 65536 + (size_t)t * 16 * 256 + 32 * ks);
#pragma unroll
                for (int ks = 0; ks < 4; ++ks) a[n++] = *(const bf16x8*)(Fm0 + (size_t)d * 16 * 32768 + (size_t)t * 16 * 128 + 32 * ks);
            }
            __builtin_amdgcn_sched_barrier(0);
            n = 0;
#pragma unroll
            for (int d = 0; d < 2; ++d) {
#pragma unroll
                for (int ks = 0; ks < 8; ++ks) if (d == 0 ? (2 * ks <= t) : (2 * ks + 1 >= t)) y[t] = __builtin_amdgcn_mfma_f32_16x16x32_bf16(a[n++], uf[ks], y[t], 0, 0, 0);
#pragma unroll
                for (int ks = 0; ks < 4; ++ks) y[t] = __builtin_amdgcn_mfma_f32_16x16x32_bf16(a[n++], hf[d][ks], y[t], 0, 0, 0);
            }
            __builtin_amdgcn_sched_barrier(0);
        }
        const f32x4 dv = *(const f32x4*)(P.in[oidx(25)] + l * 256 + 16 * g + 4 * fq);
#pragma unroll
        for (int t = 0; t < 16; ++t) {
            const size_t row = (size_t)s5_tok_row(b, cc, t);
            const u32x2 uw = *(const u32x2*)(z + row * NZ + ZU + 16 * g + 4 * fq);
            const f32x4 u = {bflo(uw.x), bfhi(uw.x), bflo(uw.y), bfhi(uw.y)};
            const f32x4 v = y[t] + dv * u;
            u32x2 w; w.x = pk2(gelu_tanh_f(v.x), gelu_tanh_f(v.y)); w.y = pk2(gelu_tanh_f(v.z), gelu_tanh_f(v.w));
            *(u32x2*)(yb + row * 256 + 16 * g + 4 * fq) = w;
        }
    }
}

template <int DQK, int MODE>
DI void attn_item(const Params& P, int l, int b, int h, int qb, LAS unsigned char* lds) {
    constexpr int KSTR = DQK * 2 + 16, NKS = DQK / 16, KCH = DQK / 8;
    constexpr int KBUF = 64 * 208, VS_OFF = 2 * KBUF, VSTR = 136, VBUF = 64 * 136, RPB_OFF = VS_OFF + 2 * VBUF;
    const int tid = otid(), wave = __builtin_amdgcn_readfirstlane(tid >> 6), lane = tid & 63, q = lane & 31, hh = lane >> 5;
    const bf16_t* Qg; const bf16_t* Kg; const bf16_t* Vt; int ldq, ldk, ocol;
    if (DQK == 96) { Qg = (const bf16_t*)(ows(P) + OFF_QM) + h * 96; ldq = 576; Kg = (const bf16_t*)(ows(P) + OFF_KM) + h * 96; ldk = 576; Vt = (const bf16_t*)(ows(P) + OFF_VTM) + (size_t)h * 64 * TT; ocol = 384 + h * 64; }
    else { Qg = (const bf16_t*)(ows(P) + OFF_Z) + ZQA + h * 64; ldq = NZ; Kg = (const bf16_t*)(ows(P) + OFF_Z) + ZKA + h * 64; ldk = NZ; Vt = (const bf16_t*)(ows(P) + OFF_VTA) + (size_t)h * 64 * TT; ocol = h * 64; }
    int qrow0, ntiles, rmin = 0, rq = 0, rs = 0;
    if (MODE == 0) { qrow0 = b * 2048 + 256 * qb + 32 * wave; ntiles = 36; }
    else if (MODE == 1) { rq = 4 * qb + (wave >> 1); qrow0 = b * 2048 + 64 * rq + 32 * (wave & 1);
        rmin = min(max(4 * qb - 4, 0), 24); const int rmax = min(max(4 * qb + 3 - 4, 0), 24) + 7; ntiles = 4 + (rmax - rmin + 1); rs = min(max(rq - 4, 0), 24); }
    else { qrow0 = TX + b * 256 + 32 * wave; ntiles = oidx(4); }
    if (MODE == 1) {
        const float* rp = P.in[oidx(12)] + (size_t)(l * 6 + h) * 465;
        for (int i = tid; i < 465; i += 512) ((LAS float*)(lds + RPB_OFF))[i] = rp[i] * LOG2E;
    }
    bf16x8 bq[NKS];
    { const bf16_t* qp = Qg + (size_t)(qrow0 + q) * ldq + 8 * hh;
#pragma unroll
      for (int ks = 0; ks < NKS; ++ks) bq[ks] = *(const bf16x8*)(qp + 16 * ks); }
    f32x16 O0, O1;
#pragma unroll
    for (int i = 0; i < 16; ++i) { O0[i] = 0.f; O1[i] = 0.f; }
    float lsum = 0.f;
    const int cq = 32 * (wave & 1) + q, cs = min(max(cq - 8, 0), 48);
    auto tile_row = [&](int i) -> int { if (i < 4) return TX + b * 256 + 64 * i; if (MODE == 1) return b * 2048 + 64 * (rmin + i - 4); return b * 2048 + 64 * (i - 4); };
    u32x4 pkA0, pkA1 = {0, 0, 0, 0}, pvA, pkB0, pkB1 = {0, 0, 0, 0}, pvB;
    auto prefetch = [&](int i, u32x4& pk0, u32x4& pk1, u32x4& pv) {
        const int r0 = tile_row(i);
        { const int c = tid, row = c / KCH, cc = c % KCH; pk0 = *(const u32x4*)(Kg + (size_t)(r0 + row) * ldk + 8 * cc); }
        if (DQK == 96) { const int c = tid + 512; if (c < 64 * KCH) { const int row = c / KCH, cc = c % KCH; pk1 = *(const u32x4*)(Kg + (size_t)(r0 + row) * ldk + 8 * cc); } }
        { const int dv = tid >> 3, cc = tid & 7; pv = *(const u32x4*)(Vt + (size_t)dv * TT + r0 + 8 * cc); }
    };
    auto stage = [&](int buf, const u32x4& pk0, const u32x4& pk1, const u32x4& pv) {
        LAS unsigned char* kb_ = lds + buf * KBUF; LAS unsigned char* vb_ = lds + VS_OFF + buf * VBUF;
        { const int c = tid, row = c / KCH, cc = c % KCH; *(LAS u32x4*)(kb_ + row * KSTR + 16 * cc) = pk0; }
        if (DQK == 96) { const int c = tid + 512; if (c < 64 * KCH) { const int row = c / KCH, cc = c % KCH; *(LAS u32x4*)(kb_ + row * KSTR + 16 * cc) = pk1; } }
        { const int dv = tid >> 3, cc = tid & 7; LAS u32x2* vp = (LAS u32x2*)(vb_ + dv * VSTR + 16 * cc); vp[0] = (u32x2){pv.x, pv.y}; vp[1] = (u32x2){pv.z, pv.w}; }
    };
    auto compute = [&](int i, int buf) {
        const LAS unsigned char* kl = lds + buf * KBUF; const LAS unsigned char* vl = lds + VS_OFF + buf * VBUF;
        bool active = true; int kr = 0;
        if (MODE == 1 && i >= 4) { kr = rmin + i - 4; active = (kr >= rs) && (kr < rs + 8); }
        if (!active) return;
        f32x16 s0, s1;
#pragma unroll
        for (int j = 0; j < 16; ++j) { s0[j] = 0.f; s1[j] = 0.f; }
        {
            constexpr int HK = 2;
#pragma unroll
            for (int hf = 0; hf < NKS / 2; ++hf) {
                bf16x8 ka0[HK], ka1[HK];
#pragma unroll
                for (int k2 = 0; k2 < HK; ++k2) { const int ks = hf * HK + k2; ka0[k2] = *(const LAS bf16x8*)(kl + q * KSTR + 32 * ks + 16 * hh); ka1[k2] = *(const LAS bf16x8*)(kl + (32 + q) * KSTR + 32 * ks + 16 * hh); }
                __builtin_amdgcn_sched_barrier(0);
#pragma unroll
                for (int k2 = 0; k2 < HK; ++k2) { const int ks = hf * HK + k2;
                    s0 = __builtin_amdgcn_mfma_f32_32x32x16_bf16(ka0[k2], bq[ks], s0, 0, 0, 0);
                    s1 = __builtin_amdgcn_mfma_f32_32x32x16_bf16(ka1[k2], bq[ks], s1, 0, 0, 0); }
                __builtin_amdgcn_sched_barrier(0);
            }
        }
        s16x4 vlo[2][2][2], vhi[2][2][2];
#pragma unroll
        for (int sp = 0; sp < 2; ++sp)
#pragma unroll
            for (int dvb = 0; dvb < 2; ++dvb) {
                const int off = (32 * dvb + q) * VSTR + (16 * sp + 4 * hh) * 2;
                vlo[0][sp][dvb] = *(const LAS s16x4*)(vl + off); vhi[0][sp][dvb] = *(const LAS s16x4*)(vl + off + 16);
            }
        __builtin_amdgcn_sched_barrier(0);
        if (MODE == 1 && i >= 4) {
            const LAS float* rb = (const LAS float*)(lds + RPB_OFF) + (kr - rq + 7) * 31;
#pragma unroll
            for (int j = 0; j < 16; ++j) {
                const int kc0 = (j & 3) + 8 * (j >> 2) + 4 * hh, kc1 = kc0 + 32;
                const int i0 = min(max(kc0 - cq + 15, 0), 30), i1 = min(max(kc1 - cq + 15, 0), 30);
                const float b0 = rb[i0], b1 = rb[i1];
                s0[j] = (kc0 >= cs && kc0 < cs + 16) ? s0[j] + b0 : -1e30f;
                s1[j] = (kc1 >= cs && kc1 < cs + 16) ? s1[j] + b1 : -1e30f;
            }
        }
        float ps = 0.f;
#pragma unroll
        for (int j = 0; j < 16; ++j) { s0[j] = fast_exp2(s0[j]); s1[j] = fast_exp2(s1[j]); ps += s0[j] + s1[j]; }
        lsum += ps;
        bf16x8 bp[2][2];
#pragma unroll
        for (int sp = 0; sp < 2; ++sp) {
            u32x4 pw;
            pw.x = pk2(s0[8 * sp + 0], s0[8 * sp + 1]); pw.y = pk2(s0[8 * sp + 2], s0[8 * sp + 3]); pw.z = pk2(s0[8 * sp + 4], s0[8 * sp + 5]); pw.w = pk2(s0[8 * sp + 6], s0[8 * sp + 7]);
            bp[0][sp] = __builtin_bit_cast(bf16x8, pw);
            pw.x = pk2(s1[8 * sp + 0], s1[8 * sp + 1]); pw.y = pk2(s1[8 * sp + 2], s1[8 * sp + 3]); pw.z = pk2(s1[8 * sp + 4], s1[8 * sp + 5]); pw.w = pk2(s1[8 * sp + 6], s1[8 * sp + 7]);
            bp[1][sp] = __builtin_bit_cast(bf16x8, pw);
        }
        __builtin_amdgcn_sched_barrier(0);
#pragma unroll
        for (int sp = 0; sp < 2; ++sp)
#pragma unroll
            for (int dvb = 0; dvb < 2; ++dvb) {
                const int off = (32 * dvb + q) * VSTR + (32 + 16 * sp + 4 * hh) * 2;
                vlo[1][sp][dvb] = *(const LAS s16x4*)(vl + off); vhi[1][sp][dvb] = *(const LAS s16x4*)(vl + off + 16);
            }
        __builtin_amdgcn_sched_barrier(0);
#pragma unroll
        for (int kb = 0; kb < 2; ++kb)
#pragma unroll
            for (int sp = 0; sp < 2; ++sp) {
                const bf16x8 av0 = __builtin_shufflevector(vlo[kb][sp][0], vhi[kb][sp][0], 0, 1, 2, 3, 4, 5, 6, 7), av1 = __builtin_shufflevector(vlo[kb][sp][1], vhi[kb][sp][1], 0, 1, 2, 3, 4, 5, 6, 7);
                O0 = __builtin_amdgcn_mfma_f32_32x32x16_bf16(av0, bp[kb][sp], O0, 0, 0, 0);
                O1 = __builtin_amdgcn_mfma_f32_32x32x16_bf16(av1, bp[kb][sp], O1, 0, 0, 0);
            }
    };
    auto compute_pair = [&]() {
        const LAS unsigned char* kA = lds + q * KSTR + 16 * hh; const LAS unsigned char* kB = kA + KBUF;
        const LAS unsigned char* vA = lds + VS_OFF + q * VSTR + 8 * hh; const LAS unsigned char* vB = vA + VBUF;
        f32x16 a0, a1, b0, b1;
#pragma unroll
        for (int j = 0; j < 16; ++j) { a0[j] = 0.f; a1[j] = 0.f; b0[j] = 0.f; b1[j] = 0.f; }
#pragma unroll
        for (int hf = 0; hf < NKS / 2; ++hf) {
            bf16x8 ka0[2], ka1[2];
#pragma unroll
            for (int k2 = 0; k2 < 2; ++k2) { const int ks = hf * 2 + k2; ka0[k2] = *(const LAS bf16x8*)(kA + 32 * ks); ka1[k2] = *(const LAS bf16x8*)(kA + 32 * KSTR + 32 * ks); }
            __builtin_amdgcn_sched_barrier(0);
#pragma unroll
            for (int k2 = 0; k2 < 2; ++k2) { const int ks = hf * 2 + k2;
                a0 = __builtin_amdgcn_mfma_f32_32x32x16_bf16(ka0[k2], bq[ks], a0, 0, 0, 0);
                a1 = __builtin_amdgcn_mfma_f32_32x32x16_bf16(ka1[k2], bq[ks], a1, 0, 0, 0); }
            __builtin_amdgcn_sched_barrier(0);
        }
        float psA = 0.f;
        { bf16x8 kf0 = *(const LAS bf16x8*)(kB), kf1 = *(const LAS bf16x8*)(kB + 32 * KSTR);
#pragma unroll
          for (int ks = 0; ks < NKS; ++ks) {
              const bf16x8 c0 = kf0, c1 = kf1;
              if (ks + 1 < NKS) { kf0 = *(const LAS bf16x8*)(kB + 32 * (ks + 1)); kf1 = *(const LAS bf16x8*)(kB + 32 * KSTR + 32 * (ks + 1)); }
              b0 = __builtin_amdgcn_mfma_f32_32x32x16_bf16(c0, bq[ks], b0, 0, 0, 0);
              b1 = __builtin_amdgcn_mfma_f32_32x32x16_bf16(c1, bq[ks], b1, 0, 0, 0);
#pragma unroll
              for (int t = (ks * 32) / NKS; t < ((ks + 1) * 32) / NKS; ++t) { if (t < 16) { a0[t] = fast_exp2(a0[t]); psA += a0[t]; } else { a1[t - 16] = fast_exp2(a1[t - 16]); psA += a1[t - 16]; } }
              __builtin_amdgcn_sched_barrier(0);
          } }
        lsum += psA;
        bf16x8 bp[2][2];
#pragma unroll
        for (int sp = 0; sp < 2; ++sp) {
            u32x4 pw;
            pw.x = pk2(a0[8 * sp + 0], a0[8 * sp + 1]); pw.y = pk2(a0[8 * sp + 2], a0[8 * sp + 3]); pw.z = pk2(a0[8 * sp + 4], a0[8 * sp + 5]); pw.w = pk2(a0[8 * sp + 6], a0[8 * sp + 7]);
            bp[0][sp] = __builtin_bit_cast(bf16x8, pw);
            pw.x = pk2(a1[8 * sp + 0], a1[8 * sp + 1]); pw.y = pk2(a1[8 * sp + 2], a1[8 * sp + 3]); pw.z = pk2(a1[8 * sp + 4], a1[8 * sp + 5]); pw.w = pk2(a1[8 * sp + 6], a1[8 * sp + 7]);
            bp[1][sp] = __builtin_bit_cast(bf16x8, pw);
        }
        float psB = 0.f;
        { s16x4 l0 = *(const LAS s16x4*)(vA), h0 = *(const LAS s16x4*)(vA + 16), l1 = *(const LAS s16x4*)(vA + 32 * VSTR), h1 = *(const LAS s16x4*)(vA + 32 * VSTR + 16);
#pragma unroll
          for (int mi = 0; mi < 4; ++mi) {
              const bf16x8 av0 = __builtin_shufflevector(l0, h0, 0, 1, 2, 3, 4, 5, 6, 7), av1 = __builtin_shufflevector(l1, h1, 0, 1, 2, 3, 4, 5, 6, 7);
              if (mi + 1 < 4) { const int off = 32 * (mi + 1); l0 = *(const LAS s16x4*)(vA + off); h0 = *(const LAS s16x4*)(vA + off + 16); l1 = *(const LAS s16x4*)(vA + 32 * VSTR + off); h1 = *(const LAS s16x4*)(vA + 32 * VSTR + off + 16); }
              O0 = __builtin_amdgcn_mfma_f32_32x32x16_bf16(av0, bp[mi >> 1][mi & 1], O0, 0, 0, 0);
              O1 = __builtin_amdgcn_mfma_f32_32x32x16_bf16(av1, bp[mi >> 1][mi & 1], O1, 0, 0, 0);
#pragma unroll
              for (int t = 8 * mi; t < 8 * mi + 8; ++t) { if (t < 16) { b0[t] = fast_exp2(b0[t]); psB += b0[t]; } else { b1[t - 16] = fast_exp2(b1[t - 16]); psB += b1[t - 16]; } }
              __builtin_amdgcn_sched_barrier(0);
          } }
        lsum += psB;
#pragma unroll
        for (int sp = 0; sp < 2; ++sp) {
            u32x4 pw;
            pw.x = pk2(b0[8 * sp + 0], b0[8 * sp + 1]); pw.y = pk2(b0[8 * sp + 2], b0[8 * sp + 3]); pw.z = pk2(b0[8 * sp + 4], b0[8 * sp + 5]); pw.w = pk2(b0[8 * sp + 6], b0[8 * sp + 7]);
            bp[0][sp] = __builtin_bit_cast(bf16x8, pw);
            pw.x = pk2(b1[8 * sp + 0], b1[8 * sp + 1]); pw.y = pk2(b1[8 * sp + 2], b1[8 * sp + 3]); pw.z = pk2(b1[8 * sp + 4], b1[8 * sp + 5]); pw.w = pk2(b1[8 * sp + 6], b1[8 * sp + 7]);
            bp[1][sp] = __builtin_bit_cast(bf16x8, pw);
        }
        { s16x4 l0 = *(const LAS s16x4*)(vB), h0 = *(const LAS s16x4*)(vB + 16), l1 = *(const LAS s16x4*)(vB + 32 * VSTR), h1 = *(const LAS s16x4*)(vB + 32 * VSTR + 16);
#pragma unroll
          for (int mi = 0; mi < 4; ++mi) {
              const bf16x8 av0 = __builtin_shufflevector(l0, h0, 0, 1, 2, 3, 4, 5, 6, 7), av1 = __builtin_shufflevector(l1, h1, 0, 1, 2, 3, 4, 5, 6, 7);
              if (mi + 1 < 4) { const int off = 32 * (mi + 1); l0 = *(const LAS s16x4*)(vB + off); h0 = *(const LAS s16x4*)(vB + off + 16); l1 = *(const LAS s16x4*)(vB + 32 * VSTR + off); h1 = *(const LAS s16x4*)(vB + 32 * VSTR + off + 16); }
              O0 = __builtin_amdgcn_mfma_f32_32x32x16_bf16(av0, bp[mi >> 1][mi & 1], O0, 0, 0, 0);
              O1 = __builtin_amdgcn_mfma_f32_32x32x16_bf16(av1, bp[mi >> 1][mi & 1], O1, 0, 0, 0);
              __builtin_amdgcn_sched_barrier(0);
          } }
    };
    prefetch(0, pkA0, pkA1, pvA);
    if (ntiles > 1) prefetch(1, pkB0, pkB1, pvB);
    for (int i = 0; i < ntiles; i += 2) {
        const bool two = i + 1 < ntiles;
        __syncthreads();
        stage(0, pkA0, pkA1, pvA);
        if (two) stage(1, pkB0, pkB1, pvB);
        __syncthreads();
        if (i + 2 < ntiles) prefetch(i + 2, pkA0, pkA1, pvA);
        if (i + 3 < ntiles) prefetch(i + 3, pkB0, pkB1, pvB);
        if (MODE != 1 && two) compute_pair();
        else { compute(i, 0); if (two) compute(i + 1, 1); }
    }
    lsum += shx(lsum, 32, lane);
    const float inv = 1.f / lsum;
    bf16_t* op = (bf16_t*)(ows(P) + OFF_OX) + (size_t)(qrow0 + q) * DM + ocol + 4 * hh;
#pragma unroll
    for (int g4 = 0; g4 < 4; ++g4) {
        u32x2 w0, w1;
        w0.x = pk2(O0[4 * g4] * inv, O0[4 * g4 + 1] * inv); w0.y = pk2(O0[4 * g4 + 2] * inv, O0[4 * g4 + 3] * inv);
        w1.x = pk2(O1[4 * g4] * inv, O1[4 * g4 + 1] * inv); w1.y = pk2(O1[4 * g4 + 2] * inv, O1[4 * g4 + 3] * inv);
        *(u32x2*)(op + 8 * g4) = w0; *(u32x2*)(op + 32 + 8 * g4) = w1;
    }
    __syncthreads();
}
DI void phase_attn(const Params& P, int l, LAS unsigned char* lds, volatile LAS unsigned* itw, int slot) {
    unsigned* ctr = (unsigned*)(ows(P) + OFF_CTR) + 16 * slot;
    const int nit = 384 + 384 + (l == 0 ? 96 : 0);
    for (;;) {
        __syncthreads();
        if (threadIdx.x == 0) *itw = atomicAdd(ctr, 1u);
        __syncthreads();
        const int it = (int)*itw;
        if (it >= nit) break;
        if (it < 384) { const int qb = it & 7, h = (it >> 3) % 6, b = it / 48; attn_item<96, 0>(P, l, b, h, qb, lds); }
        else if (it < 768) { const int j = it - 384; const int qb = j & 7, h = (j >> 3) % 6, b = j / 48; attn_item<64, 1>(P, l, b, h, qb, lds); }
        else { const int j = it - 768; const int hd = j % 12, b = j / 12; if (hd < 6) attn_item<64, 2>(P, l, b, hd, 0, lds); else attn_item<96, 2>(P, l, b, hd - 6, 0, lds); }
    }
}

__global__ void __launch_bounds__(512, 2) fwd_megakernel(Params P) {
    extern __shared__ __attribute__((aligned(16))) unsigned char smem[];
    __shared__ __attribute__((aligned(16))) unsigned sh_words[4];
    LAS unsigned char* lds = (LAS unsigned char*)smem;
    if (threadIdx.x < 4) sh_words[threadIdx.x] = 0u;
    __syncthreads();
    XcdBarrier xb = xcd_barrier_post((unsigned*)(ows(P) + OFF_BAR), (volatile LAS unsigned*)sh_words);
    volatile LAS unsigned* itw = (volatile LAS unsigned*)sh_words + 2;

    phase_prep(P, lds);
    if (P.ws == nullptr) cg::this_grid().sync();
    xcd_barrier(xb);

    for (int l = 0; l < 2; ++l) {
        const float* ml = (const float*)(ows(P) + OFF_MODS) + (size_t)l * 9 * 9216;
        const float* sx = l == 0 ? P.in[oidx(0)] : P.out; float* sc = ((float*)(ows(P) + OFF_HXC));
        const int M2 = l == 0 ? TT : TX;
        phase_modulate(sx, sc, TT, P.in[oidx(6)] + (l * 3 + 0) * 1024, ml + 0 * 1024, ml + 1 * 1024, ((bf16_t*)(ows(P) + OFF_A)), l == 1 ? (const float*)(ows(P) + OFF_OX) : (const float*)nullptr);
        xcd_barrier(xb);
        { pg8::EpiSwiglu e; e.H = ((bf16_t*)(ows(P) + OFF_H)); e.ldh = DFF; gemm_call(lds, ((bf16_t*)(ows(P) + OFF_A)), DM, (const bf16_t*)(ows(P) + OFF_WGU) + (size_t)(l * 2 + 0) * 5632 * 1024, 1024, TT, 5632, 1024, e, 0); }
        if (gridDim.x == 256) deferred_transposes(P, lds, l == 0 ? 0 : 99, 48);
        xcd_barrier(xb);
        { pg8::EpiResid e; e.rin_x = sx; e.rin_c = sc; e.rout_x = P.out; e.rout_c = ((float*)(ows(P) + OFF_HXC)); e.gate = ml + 2 * 1024; e.gs = 0.5f;
          gemm_call(lds, ((bf16_t*)(ows(P) + OFF_H)), DFF, (const bf16_t*)(ows(P) + OFF_WDN) + (size_t)(l * 2 + 0) * 1024 * 2816, 2816, TX, 1024, 2816, e, 0); }
        for (int kq = 0; kq < 4; ++kq) {
          const int koff = kq < 2 ? 768 * kq : 1536 + 640 * (kq - 2), klen = kq < 2 ? 768 : 640;
          pg8::EpiResidAtomicC e; e.rout_c = ((float*)(ows(P) + OFF_OX)) + (size_t)kq * TC * DM; e.gate = ml + 2 * 1024; e.gs = 0.5f;
          gemm_call(lds, ((bf16_t*)(ows(P) + OFF_H)) + (size_t)TX * DFF + koff, DFF, (const bf16_t*)(ows(P) + OFF_WDN) + (size_t)(l * 2 + 0) * 1024 * 2816 + koff, 2816, TC, 1024, klen, e, 256 - 32 * kq); }
        if (gridDim.x == 256) deferred_transposes(P, lds, l == 0 ? 1 : 99, 128);
        xcd_barrier(xb);
        phase_modulate(P.out, ((float*)(ows(P) + OFF_HXC)), TT, P.in[oidx(6)] + (l * 3 + 1) * 1024, ml + 3 * 1024, ml + 4 * 1024, ((bf16_t*)(ows(P) + OFF_A)), (const float*)(ows(P) + OFF_OX));
        xcd_barrier(xb);
        { pg8::EpiStore e; e.O = ((bf16_t*)(ows(P) + OFF_Z)); e.ldo = NZ; e.rows_valid = TT; e.cols_valid = NZ; e.kmap = 0;
          gemm_call(lds, ((bf16_t*)(ows(P) + OFF_A)), DM, (const bf16_t*)(ows(P) + OFF_WIN) + (size_t)l * NZ * 1024, 1024, TT, NZ, 1024, e, 0); }
        xcd_barrier(xb);
        phase_znorm(P, l);
        phase_s5_s1(P, l);
        xcd_barrier(xb);
        phase_s5_s2(P, l, lds);
        { pg8::EpiStore e; e.O = (bf16_t*)(ows(P) + OFF_QM); e.ldo = 576; e.rows_valid = TT; e.cols_valid = 576; e.kmap = 0;
          gemm_call(lds, ((bf16_t*)(ows(P) + OFF_Z)) + ZCQ, NZ, (const bf16_t*)(ows(P) + OFF_WUQ) + (size_t)l * 768 * 384, 384, l == 0 ? TT : TX, 768, 384, e, 0); }
        { pg8::EpiStore e; e.O = (bf16_t*)(ows(P) + OFF_KM); e.ldo = 576; e.rows_valid = TT; e.cols_valid = 384; e.kmap = 1;
          gemm_call(lds, ((bf16_t*)(ows(P) + OFF_Z)) + ZCKV, NZ, (const bf16_t*)(ows(P) + OFF_WUK) + (size_t)l * 512 * 256, 256, TT, 512, 256, e, 40); }
        { pg8::EpiStore e; e.O = (bf16_t*)(ows(P) + OFF_VTM); e.ldo = TT; e.rows_valid = 384; e.cols_valid = TT; e.kmap = 0;
          gemm_call(lds, (const bf16_t*)(ows(P) + OFF_WUV) + (size_t)l * 512 * 256, 256, ((bf16_t*)(ows(P) + OFF_Z)) + ZCKV, NZ, 512, TT, 256, e, 152); }
        { pg8::EpiStore e; e.O = (bf16_t*)(ows(P) + OFF_VTA); e.ldo = TT; e.rows_valid = 384; e.cols_valid = TT; e.kmap = 0;
          gemm_call(lds, (const bf16_t*)(ows(P) + OFF_WVA) + (size_t)l * 512 * 1024, 1024, ((bf16_t*)(ows(P) + OFF_A)), DM, 512, TT, 1024, e, 8); }
        xcd_barrier(xb);
        phase_finish(P, l);
        phase_s5_s3(P, l);
        xcd_barrier(xb);
        { pg8::EpiGlu e; e.O = ((bf16_t*)(ows(P) + OFF_OX)); e.ldo = DM; e.col_base = 768; e.bias = P.in[oidx(27)] + l * 512;
          gemm_call(lds, (const bf16_t*)(ows(P) + OFF_YB), 256, (const bf16_t*)(ows(P) + OFF_WGLU) + (size_t)l * 512 * 256, 256, M2, 512, 256, e, 0); }
        phase_attn(P, l, lds, itw, l * 2 + 1);
        xcd_barrier(xb);
        { pg8::EpiResid e; e.rin_x = P.out; e.rin_c = ((float*)(ows(P) + OFF_HXC)); e.rout_x = P.out; e.rout_c = ((float*)(ows(P) + OFF_HXC)); e.gate = ml + 5 * 1024; e.gs = 1.0f;
          gemm_call(lds, ((bf16_t*)(ows(P) + OFF_OX)), DM, (const bf16_t*)(ows(P) + OFF_WOUT) + (size_t)l * 1024 * 1024, 1024, TX, 1024, 1024, e, 0); }
        if (l == 0) for (int kq = 0; kq < 4; ++kq) {
          pg8::EpiResidAtomicC e; e.rout_c = ((float*)(ows(P) + OFF_Z)) + (size_t)kq * TC * DM; e.gate = ml + 5 * 1024; e.gs = 1.0f;
          gemm_call(lds, ((bf16_t*)(ows(P) + OFF_OX)) + (size_t)TX * DM + kq * 256, DM, (const bf16_t*)(ows(P) + OFF_WOUT) + (size_t)l * 1024 * 1024 + kq * 256, 1024, TC, 1024, 256, e, 256 - 32 * kq); }
        xcd_barrier(xb);
        phase_modulate(P.out, ((float*)(ows(P) + OFF_HXC)), M2, P.in[oidx(6)] + (l * 3 + 2) * 1024, ml + 6 * 1024, ml + 7 * 1024, ((bf16_t*)(ows(P) + OFF_A)), l == 0 ? (const float*)(ows(P) + OFF_Z) : (const float*)nullptr);
        xcd_barrier(xb);
        { pg8::EpiSwiglu e; e.H = ((bf16_t*)(ows(P) + OFF_H)); e.ldh = DFF; gemm_call(lds, ((bf16_t*)(ows(P) + OFF_A)), DM, (const bf16_t*)(ows(P) + OFF_WGU) + (size_t)(l * 2 + 1) * 5632 * 1024, 1024, M2, 5632, 1024, e, 0); }
        if (gridDim.x == 256) deferred_transposes(P, lds, l == 0 ? 2 : 99, 48);
        xcd_barrier(xb);
        { pg8::EpiResid e; e.rin_x = P.out; e.rin_c = ((float*)(ows(P) + OFF_HXC)); e.rout_x = P.out; e.rout_c = ((float*)(ows(P) + OFF_HXC)); e.gate = ml + 8 * 1024; e.gs = 0.5f;
          gemm_call(lds, ((bf16_t*)(ows(P) + OFF_H)), DFF, (const bf16_t*)(ows(P) + OFF_WDN) + (size_t)(l * 2 + 1) * 1024 * 2816, 2816, TX, 1024, 2816, e, 0); }
        if (l == 0) for (int kq = 0; kq < 4; ++kq) {
          const int koff = kq < 2 ? 768 * kq : 1536 + 640 * (kq - 2), klen = kq < 2 ? 768 : 640;
          pg8::EpiResidAtomicC e; e.rout_c = ((float*)(ows(P) + OFF_OX)) + (size_t)kq * TC * DM; e.gate = ml + 8 * 1024; e.gs = 0.5f;
          gemm_call(lds, ((bf16_t*)(ows(P) + OFF_H)) + (size_t)TX * DFF + koff, DFF, (const bf16_t*)(ows(P) + OFF_WDN) + (size_t)(l * 2 + 1) * 1024 * 2816 + koff, 2816, TC, 1024, klen, e, 256 - 32 * kq); }
        if (gridDim.x == 256) deferred_transposes(P, lds, l == 0 ? 3 : 99, 128);
        if (l == 0) xcd_barrier(xb);
    }
}

constexpr int LDS_BYTES = 131072;
extern "C" void kernel_launch(void* const* d_in, const int* in_sizes, int n_in, void* d_out, int out_size, void* d_ws, size_t ws_size, hipStream_t stream) {
    static int grid = 0;
    if (grid == 0) {
        if (n_in != 28 || ws_size < WS_END) { fprintf(stderr, "kernel_launch: unexpected inputs (n_in %d, ws %zu < %zu)\n", n_in, ws_size, (size_t)WS_END); grid = -1; return; }
        int dev = 0, cus = 0, per_cu = 0;
        hipGetDevice(&dev); hipDeviceGetAttribute(&cus, hipDeviceAttributeMultiprocessorCount, dev);
        if (hipFuncSetAttribute((const void*)fwd_megakernel, hipFuncAttributeMaxDynamicSharedMemorySize, LDS_BYTES) != hipSuccess) { fprintf(stderr, "kernel_launch: hipFuncSetAttribute failed\n"); grid = -1; return; }
        hipOccupancyMaxActiveBlocksPerMultiprocessor(&per_cu, (const void*)fwd_megakernel, 512, LDS_BYTES);
        if (per_cu < 1) { fprintf(stderr, "kernel_launch: occupancy query says %d\n", per_cu); per_cu = 1; }
        (void)hipGetLastError();
        grid = cus;
    }
    if (grid < 0) return;
    hipMemsetAsync((char*)d_ws + OFF_BAR, 0, 20480, stream);
    Params p{};
    for (int i = 0; i < 28; ++i) p.in[i] = (const float*)d_in[i];
    p.out = (float*)d_out; p.ws = (unsigned char*)d_ws;
    void* args[] = {&p};
    hipError_t e = hipLaunchCooperativeKernel((const void*)fwd_megakernel, dim3(grid), dim3(512), args, LDS_BYTES, stream);
    if (e != hipSuccess) fprintf(stderr, "cooperative launch failed: %s (grid %d)\n", hipGetErrorString(e), grid);
}
```

```cpp
#include <hip/hip_runtime.h>
#include <hip/hip_cooperative_groups.h>
#include <cstdio>
namespace cg = cooperative_groups;

#define LAS __attribute__((address_space(3)))
#define DI __device__ __forceinline__
typedef unsigned short bf16_t;
typedef short bf16x8 __attribute__((ext_vector_type(8)));
typedef short s16x4 __attribute__((ext_vector_type(4)));
typedef float f32x2 __attribute__((ext_vector_type(2)));
typedef float f32x4 __attribute__((ext_vector_type(4)));
typedef float f32x16 __attribute__((ext_vector_type(16)));
typedef unsigned u32x2 __attribute__((ext_vector_type(2)));
typedef unsigned u32x4 __attribute__((ext_vector_type(4)));
typedef __bf16 bf2_t __attribute__((ext_vector_type(2)));

constexpr int DM = 1024, NB = 8, SEQ = 2048, CTXL = 256;
constexpr int TX = NB * SEQ, TC = NB * CTXL, TT = TX + TC;
constexpr int DFF = 2816, NZ = 1792;
constexpr int ZQA = 0, ZKA = 384, ZCQ = 768, ZCKV = 1152, ZKR = 1408, ZU = 1440;
constexpr float EPSN = 1e-6f, LOG2E = 1.4426950408889634f;
constexpr int NCH = 36;

constexpr size_t SZ_WGU = (size_t)4 * 5632 * 1024 * 2, SZ_WDN = (size_t)4 * 1024 * 2816 * 2, SZ_WIN = (size_t)2 * NZ * 1024 * 2;
constexpr size_t SZ_WVA = (size_t)2 * 512 * 1024 * 2, SZ_WOUT = (size_t)2 * 1024 * 1024 * 2, SZ_WUQ = (size_t)2 * 768 * 384 * 2;
constexpr size_t SZ_WUK = (size_t)2 * 512 * 256 * 2, SZ_WUV = SZ_WUK, SZ_WGLU = SZ_WUK;
constexpr size_t OFF_BAR = 0;
constexpr size_t OFF_CTR = 16384;
constexpr size_t OFF_WGU = 20480;
constexpr size_t OFF_WDN = OFF_WGU + SZ_WGU;
constexpr size_t OFF_WIN = OFF_WDN + SZ_WDN;
constexpr size_t OFF_WVA = OFF_WIN + SZ_WIN;
constexpr size_t OFF_WOUT = OFF_WVA + SZ_WVA;
constexpr size_t OFF_WUQ = OFF_WOUT + SZ_WOUT;
constexpr size_t OFF_WUK = OFF_WUQ + SZ_WUQ;
constexpr size_t OFF_WUV = OFF_WUK + SZ_WUK;
constexpr size_t OFF_WGLU = OFF_WUV + SZ_WUV;
constexpr size_t OFF_MODS = OFF_WGLU + SZ_WGLU;
constexpr size_t OFF_ROPE = OFF_MODS + 663552;
constexpr size_t OFF_S5LAM = OFF_ROPE + 4096;
constexpr size_t OFF_S5BB = OFF_S5LAM + 65536;
constexpr size_t OFF_S5CA = OFF_S5BB + 524288;
constexpr size_t OFF_HXC = OFF_S5CA + 262144;
constexpr size_t OFF_A = OFF_HXC + (size_t)TC * DM * 4;
constexpr size_t OFF_OX = OFF_A + (size_t)TT * DM * 2;
constexpr size_t OFF_H = OFF_OX + (size_t)TT * DM * 2;
constexpr size_t OFF_Z = OFF_H;
constexpr size_t OFF_QM = OFF_Z + (size_t)TT * NZ * 2;
constexpr size_t OFF_VTA = OFF_QM + (size_t)TT * 576 * 2;
constexpr size_t OFF_KM = OFF_H + (size_t)TT * DFF * 2;
constexpr size_t OFF_VTM = OFF_KM + (size_t)TT * 576 * 2;
constexpr size_t OFF_YB = OFF_VTM + (size_t)384 * TT * 2;
constexpr size_t OFF_S5K = OFF_YB + (size_t)TT * 256 * 2;
constexpr size_t OFF_S5E = OFF_S5K + (size_t)64 * 65536 * 2;
constexpr size_t OFF_S5F = OFF_S5E + (size_t)64 * 32768 * 2;
constexpr size_t OFF_S5L16 = OFF_S5F + (size_t)64 * 32768 * 2;
constexpr size_t WS_END = OFF_S5L16 + (size_t)64 * 64 * 8;
static_assert((size_t)4 * TC * DM * 4 <= (size_t)TT * DM * 2, "slab alias overflow");
static_assert(WS_END <= (size_t)352 * 1024 * 1024, "workspace above the guaranteed 4 x largest tensor");
constexpr size_t OFF_SE = OFF_OX;
constexpr size_t OFF_SH = OFF_OX + (size_t)8 * 16 * 2 * 144 * 128 * 4;
static_assert((size_t)8 * 16 * 2 * 144 * 128 * 6 <= (size_t)TT * DM * 2, "S5 alias overflow");
static_assert(OFF_VTA + (size_t)384 * TT * 2 <= OFF_KM, "alias overflow");

struct Params { const float* in[28]; float* out; unsigned char* ws; };

DI unsigned char* ows(const Params& P) { unsigned zero = 0; asm volatile("" : "+s"(zero)); return P.ws + zero; }
DI unsigned pk2(float a, float b) { f32x2 v; v.x = a; v.y = b; return __builtin_bit_cast(unsigned, __builtin_convertvector(v, bf2_t)); }
DI float bflo(unsigned w) { return __uint_as_float(w << 16); }
DI float bfhi(unsigned w) { return __uint_as_float(w & 0xffff0000u); }
DI void unpack8(const u32x4 w, float (&f)[8]) { f[0] = bflo(w.x); f[1] = bfhi(w.x); f[2] = bflo(w.y); f[3] = bfhi(w.y); f[4] = bflo(w.z); f[5] = bfhi(w.z); f[6] = bflo(w.w); f[7] = bfhi(w.w); }
DI u32x4 pack8(const float (&f)[8]) { u32x4 w; w.x = pk2(f[0], f[1]); w.y = pk2(f[2], f[3]); w.z = pk2(f[4], f[5]); w.w = pk2(f[6], f[7]); return w; }
DI float shx(float v, int o, int lane) { return __int_as_float(__builtin_amdgcn_ds_bpermute((lane ^ o) << 2, __float_as_int(v))); }
DI float wave_sum(float v, int lane) {
#pragma unroll
    for (int o = 1; o < 64; o <<= 1) v += shx(v, o, lane);
    return v;
}
DI float fast_exp2(float x) { return __builtin_amdgcn_exp2f(x); }
DI float fast_rcp(float x) { return __builtin_amdgcn_rcpf(x); }
DI float silu_f(float x) { return x * fast_rcp(1.f + fast_exp2(-x * LOG2E)); }
DI float sigmoid_f(float x) { return fast_rcp(1.f + fast_exp2(-x * LOG2E)); }
DI float gelu_tanh_f(float y) { const float t = 0.7978845608028654f * (y + 0.044715f * y * y * y); const float e = fast_exp2(2.f * LOG2E * t); const float th = 1.f - 2.f * fast_rcp(e + 1.f); return 0.5f * y * (1.f + th); }
#define LDS_WAIT() asm volatile("s_waitcnt lgkmcnt(0)" ::: "memory")
DI int otid() { int t = threadIdx.x; asm volatile("" : "+v"(t)); return t; }
DI int oidx(int i) { asm volatile("" : "+s"(i)); return i; }
DI int obid() { int b = blockIdx.x; asm volatile("" : "+s"(b)); return b; }

#define XB_TMO      128
#define XB_XCNT(j)  (256  + 64 * (j))
#define XB_XSUB(j)  (1280 + 64 * (j))
#define XB_XGEN(j)  (2304 + 64 * (j))
#define XB_TOP      3328
#define XB_TOPGEN   3392
#define XCD_BAR_WORDS 3456
#define XB_SPIN_CAP (1u << 20)
DI unsigned xb_ld(unsigned* p) { return __hip_atomic_load(p, __ATOMIC_RELAXED, __HIP_MEMORY_SCOPE_AGENT); }
DI unsigned xb_add(unsigned* p, unsigned v) { return __hip_atomic_fetch_add(p, v, __ATOMIC_RELAXED, __HIP_MEMORY_SCOPE_AGENT); }
DI unsigned xb_xcc_id() { return (unsigned)__builtin_amdgcn_s_getreg((3 << 11) | 20) & 0xFu; }
#define XB_SPIN(cond, bar) do { unsigned _sp = 0; while (cond) { __builtin_amdgcn_s_sleep(1); \
    if ((++_sp & 255u) == 0u) { if (xb_ld(&(bar)[XB_TMO])) break; if (_sp > XB_SPIN_CAP) { atomicAdd(&(bar)[XB_TMO], 1u); break; } } } } while (0)
struct XcdBarrier { unsigned* bar; unsigned x; volatile LAS unsigned* st; };
DI XcdBarrier xcd_barrier_post(unsigned* bar, volatile LAS unsigned* st) {
    XcdBarrier b; b.bar = bar; b.x = xb_xcc_id(); b.st = st;
    if (threadIdx.x == 0) (void)xb_add(&bar[XB_XCNT(b.x)], 1u);
    return b;
}
DI void xcd_barrier_complete(unsigned* bar, unsigned x, unsigned& nloc, unsigned& nx) {
    const unsigned G = gridDim.x * gridDim.y * gridDim.z;
    unsigned sum, cnt, mine, sp = 0u;
    for (;;) {
        sum = 0u; cnt = 0u; mine = 0u;
#pragma unroll
        for (unsigned j = 0; j < 16; ++j) { const unsigned c = xb_ld(&bar[XB_XCNT(j)]); sum += c; cnt += (c > 0u) ? 1u : 0u; mine = (j == x) ? c : mine; }
        if (sum == G) break;
        __builtin_amdgcn_s_sleep(1);
        if ((++sp & 255u) == 0u) { if (xb_ld(&bar[XB_TMO])) break; if (sp > XB_SPIN_CAP) { atomicAdd(&bar[XB_TMO], 1u); break; } }
    }
    nloc = mine > 0u ? mine : 1u; nx = cnt > 0u ? cnt : 1u;
}
DI void xcd_barrier(const XcdBarrier& b) {
    asm volatile("s_waitcnt vmcnt(0)" ::: "memory");
    __syncthreads();
    if (threadIdx.x == 0) {
        const unsigned long long ba = (unsigned long long)b.bar;
        unsigned blo = (unsigned)__builtin_amdgcn_readfirstlane((int)(unsigned)ba), bhi = (unsigned)__builtin_amdgcn_readfirstlane((int)(unsigned)(ba >> 32));
        asm volatile("" : "+s"(blo), "+s"(bhi));
        unsigned* bar = (unsigned*)(((unsigned long long)bhi << 32) | blo);
        const unsigned bx = (unsigned)__builtin_amdgcn_readfirstlane((int)b.x);
        __builtin_amdgcn_s_waitcnt(0);
        unsigned nloc = b.st[0], nx = b.st[1];
        if (nloc == 0u) { xcd_barrier_complete(bar, bx, nloc, nx); b.st[0] = nloc; b.st[1] = nx; }
        const unsigned old = xb_add(&bar[XB_XSUB(bx)], 1u);
        const unsigned gen = old / nloc;
        if (old + 1u == (gen + 1u) * nloc) {
            __builtin_amdgcn_fence(__ATOMIC_RELEASE, "agent");
            asm volatile("s_waitcnt vmcnt(0)" ::: "memory");
            const unsigned og = xb_add(&bar[XB_TOP], 1u);
            const unsigned tg = og / nx;
            if (og + 1u == (tg + 1u) * nx) xb_add(&bar[XB_TOPGEN], 1u);
            else XB_SPIN(xb_ld(&bar[XB_TOPGEN]) == tg, bar);
            __builtin_amdgcn_fence(__ATOMIC_ACQUIRE, "agent");
            xb_add(&bar[XB_XGEN(bx)], 1u);
            asm volatile("s_waitcnt vmcnt(0)" ::: "memory");
        } else {
            XB_SPIN(xb_ld(&bar[XB_XGEN(bx)]) == gen, bar);
            __builtin_amdgcn_fence(__ATOMIC_ACQUIRE, "agent");
            asm volatile("s_waitcnt vmcnt(0)" ::: "memory");
        }
    }
    __syncthreads();
}

namespace pg8 {
constexpr int BM = 256, BK = 64, HALF = 128, HTB = HALF * BK * 2, STAGE_BYTES = 8 * HTB, NXCD = 8, WGM = 8;
DI int lds_byte(int r, int c) { const int st = (r >> 4) * 2 + (c >> 5), rr = r & 15, cc = c & 31, ob = rr * 64 + cc * 2; return st * 1024 + (ob ^ (((ob >> 9) & 1) << 5)); }
DI void stage_rc(int b, int& R, int& C) { const int st = b / 1024, sb = b % 1024, swz = sb ^ (((sb >> 9) & 1) << 5); R = (st >> 1) * 16 + swz / 64; C = (st & 1) * 32 + (swz % 64) / 2; }
DI int perm32(int rho) { const int n = rho >> 4, i = rho & 15; return 8 * (i >> 2) + 4 * n + (i & 3); }
struct Unit { int pm, pn; };
struct Gemm { const bf16_t* A; const bf16_t* Bt; int lda, ldb; int M, N, K; };
struct StaticOrder {
    int nM, nN, nwg, G, c;
    DI void init(int M, int N, int G_, int c_) { nM = M / BM; nN = N / BM; nwg = nM * nN; G = G_; c = c_; }
    DI bool next(int i, Unit& u) const {
        const long L = (long)i * G + c; if (L >= nwg) return false;
        int wgid = (int)L; { const int q = nwg / NXCD, r = nwg % NXCD, xcd = wgid % NXCD, off = wgid / NXCD; wgid = (xcd < r ? xcd * (q + 1) : r * (q + 1) + (xcd - r) * q) + off; }
        const int nig = WGM * nN, gid = wgid / nig, fm = gid * WGM, gsz = (nM - fm) < WGM ? (nM - fm) : WGM;
        u.pm = fm + ((wgid % nig) % gsz); u.pn = (wgid % nig) / gsz; return true;
    }
};

template <class Epi>
DI void gemm_phase(LAS unsigned char* lds, const Gemm g, const StaticOrder& S, const Epi& E) {
    const int tid = otid(), wid = __builtin_amdgcn_readfirstlane(tid >> 6), lane = tid & 63, wr = wid >> 2, wc = wid & 3, fr = lane & 15, fq = lane >> 4;
    const int K = g.K, nt = K / BK;
    unsigned voffA[2], voffB[2];
#pragma unroll
    for (int i = 0; i < 2; ++i) { int R, C; stage_rc(tid * 16 + i * 8192, R, C); const int Rb = Epi::PERM ? ((R & ~31) + perm32(R & 31)) : R;
        voffA[i] = (unsigned)(R * g.lda + C) * 2u; voffB[i] = (unsigned)(Rb * g.ldb + C) * 2u; }
    const size_t kstep = (size_t)(BK * 2);
    const size_t hstepA = (size_t)HALF * g.lda * 2, hstepB = (size_t)HALF * g.ldb * 2;
    const size_t tstepA = 2 * hstepA, tstepB = 2 * hstepB;
    const unsigned ldsw = (unsigned)wid * 1024u;
    const int aoff = lds_byte(wr * 64 + fr, fq * 8), boff = lds_byte(wc * 32 + fr, fq * 8);
#define PG8_SA(b, h) (((b) * 2 + (h)) * HTB)
#define PG8_SB(b, h) ((4 + (b) * 2 + (h)) * HTB)
#define PG8_STAGE(bufoff, gbase, voff) do { _Pragma("unroll") for (int _i = 0; _i < 2; ++_i) \
        __builtin_amdgcn_global_load_lds((const unsigned*)((const char*)(gbase) + (voff)[_i]), (LAS unsigned*)(lds + (bufoff) + ldsw + _i * 8192), 16, 0, 0); } while (0)
#define PG8_LDA(dst, b, h) do { _Pragma("unroll") for (int m = 0; m < 4; ++m) _Pragma("unroll") for (int k = 0; k < 2; ++k) dst[m][k] = *(const LAS bf16x8*)(lds + PG8_SA(b, h) + aoff + m * 2048 + k * 1024); } while (0)
#define PG8_LDB(dst, b, h) do { _Pragma("unroll") for (int n = 0; n < 2; ++n) _Pragma("unroll") for (int k = 0; k < 2; ++k) dst[n][k] = *(const LAS bf16x8*)(lds + PG8_SB(b, h) + boff + n * 2048 + k * 1024); } while (0)
#define PG8_MMA(ai, bj, At, Bt) do { __builtin_amdgcn_s_setprio(1); _Pragma("unroll") for (int m = 0; m < 4; ++m) _Pragma("unroll") for (int n = 0; n < 2; ++n) _Pragma("unroll") for (int k = 0; k < 2; ++k) \
        acc[ai][bj][m][n] = __builtin_amdgcn_mfma_f32_16x16x32_bf16(Bt[n][k], At[m][k], acc[ai][bj][m][n], 0, 0, 0); __builtin_amdgcn_s_setprio(0); } while (0)
#define PG8_WAIT_V(n) asm volatile("s_waitcnt vmcnt(" #n ")" ::: "memory")
#define PG8_WAIT_L(n) asm volatile("s_waitcnt lgkmcnt(" #n ")" ::: "memory")
#define PG8_BAR __builtin_amdgcn_s_barrier()
#define PG8_SCHED __builtin_amdgcn_sched_barrier(0)
    Unit cur, nxt; int ui = 0;
    if (!S.next(0, cur)) return;
    f32x4 acc[2][2][4][2];
#pragma unroll
    for (int a = 0; a < 2; ++a)
#pragma unroll
        for (int b = 0; b < 2; ++b)
#pragma unroll
            for (int m = 0; m < 4; ++m)
#pragma unroll
                for (int n = 0; n < 2; ++n) acc[a][b][m][n] = (f32x4){0.f, 0.f, 0.f, 0.f};
    bf16x8 At[4][2], B0[2][2], B1[2][2];
    const char* cA = (const char*)g.A + (size_t)cur.pm * tstepA; const char* cB = (const char*)g.Bt + (size_t)cur.pn * tstepB;
    PG8_STAGE(PG8_SB(0, 0), cB, voffB); PG8_STAGE(PG8_SA(0, 0), cA, voffA); PG8_STAGE(PG8_SB(0, 1), cB + hstepB, voffB); PG8_STAGE(PG8_SA(0, 1), cA + hstepA, voffA);
    if (wr == 1) PG8_BAR;
    PG8_WAIT_V(4); PG8_BAR;
    PG8_STAGE(PG8_SB(1, 0), cB + kstep, voffB); PG8_STAGE(PG8_SA(1, 0), cA + kstep, voffA); PG8_STAGE(PG8_SB(1, 1), cB + hstepB + kstep, voffB);
    PG8_WAIT_V(6); PG8_BAR;
    for (;;) {
        const bool has_next = S.next(ui + 1, nxt);
        const char* nA = has_next ? (const char*)g.A + (size_t)nxt.pm * tstepA : cA; const char* nB = has_next ? (const char*)g.Bt + (size_t)nxt.pn * tstepB : cB;
        for (int t = 0; t < nt; t += 2) {
            const bool last = (t == nt - 2);
            const char* a1 = cA + (size_t)(t + 1) * kstep;
            const char* a2 = last ? nA : cA + (size_t)(t + 2) * kstep; const char* b2 = last ? nB : cB + (size_t)(t + 2) * kstep;
            const char* a3 = a2 + kstep; const char* b3 = b2 + kstep;
            PG8_LDB(B0, 0, 0); PG8_SCHED; PG8_LDA(At, 0, 0); PG8_STAGE(PG8_SA(1, 1), a1 + hstepA, voffA);
            PG8_WAIT_L(8); PG8_BAR; PG8_WAIT_L(0); PG8_MMA(0, 0, At, B0); PG8_BAR; PG8_SCHED;
            PG8_LDB(B1, 0, 1); PG8_STAGE(PG8_SB(0, 0), b2, voffB);
            PG8_BAR; PG8_WAIT_L(0); PG8_MMA(0, 1, At, B1); PG8_BAR;
            PG8_LDA(At, 0, 1); PG8_STAGE(PG8_SA(0, 0), a2, voffA);
            PG8_BAR; PG8_WAIT_L(0); PG8_MMA(1, 0, At, B0); PG8_BAR; PG8_SCHED;
            PG8_STAGE(PG8_SB(0, 1), b2 + hstepB, voffB);
            PG8_WAIT_V(6); PG8_BAR; PG8_MMA(1, 1, At, B1); PG8_BAR;
            PG8_LDB(B0, 1, 0); PG8_SCHED; PG8_LDA(At, 1, 0); PG8_STAGE(PG8_SA(0, 1), a2 + hstepA, voffA);
            PG8_WAIT_L(8); PG8_BAR; PG8_WAIT_L(0); PG8_MMA(0, 0, At, B0); PG8_BAR; PG8_SCHED;
            PG8_LDB(B1, 1, 1); PG8_STAGE(PG8_SB(1, 0), b3, voffB);
            PG8_BAR; PG8_WAIT_L(0); PG8_MMA(0, 1, At, B1); PG8_BAR;
            PG8_LDA(At, 1, 1); PG8_STAGE(PG8_SA(1, 0), a3, voffA);
            PG8_BAR; PG8_WAIT_L(0); PG8_MMA(1, 0, At, B0); PG8_BAR; PG8_SCHED;
            PG8_STAGE(PG8_SB(1, 1), b3 + hstepB, voffB);
            PG8_WAIT_V(6); PG8_BAR; PG8_MMA(1, 1, At, B1); PG8_BAR;
        }
        E(acc, cur, wr, wc, fr, fq);
        if (!has_next) break;
#pragma unroll
        for (int a = 0; a < 2; ++a)
#pragma unroll
            for (int b = 0; b < 2; ++b)
#pragma unroll
                for (int m = 0; m < 4; ++m)
#pragma unroll
                    for (int n = 0; n < 2; ++n) acc[a][b][m][n] = (f32x4){0.f, 0.f, 0.f, 0.f};
        cur = nxt; cA = nA; cB = nB; ++ui;
    }
    PG8_WAIT_V(0);
    if (wr == 0) PG8_BAR;
    PG8_BAR;
#undef PG8_SA
#undef PG8_SB
#undef PG8_STAGE
#undef PG8_LDA
#undef PG8_LDB
#undef PG8_MMA
#undef PG8_WAIT_V
#undef PG8_WAIT_L
#undef PG8_BAR
#undef PG8_SCHED
}

struct EpiSwiglu {
    static constexpr bool PERM = true;
    bf16_t* H; int ldh;
    DI void operator()(const f32x4 (&acc)[2][2][4][2], const Unit& u, int wr, int wc, int fr, int fq) const {
        const int row0 = u.pm * BM + wr * 64 + fr, col0 = u.pn * HALF + wc * 32 + 8 * fq;
#pragma unroll
        for (int ai = 0; ai < 2; ++ai)
#pragma unroll
            for (int m = 0; m < 4; ++m) {
                bf16_t* rowp = H + (size_t)(row0 + ai * HALF + m * 16) * ldh + col0;
                const f32x4 g0 = acc[ai][0][m][0], g1 = acc[ai][0][m][1], u0 = acc[ai][1][m][0], u1 = acc[ai][1][m][1];
                u32x4 w;
                w.x = pk2(silu_f(g0[0]) * u0[0], silu_f(g0[1]) * u0[1]); w.y = pk2(silu_f(g0[2]) * u0[2], silu_f(g0[3]) * u0[3]);
                w.z = pk2(silu_f(g1[0]) * u1[0], silu_f(g1[1]) * u1[1]); w.w = pk2(silu_f(g1[2]) * u1[2], silu_f(g1[3]) * u1[3]);
                *(u32x4*)rowp = w;
            }
    }
};
struct EpiGlu {
    static constexpr bool PERM = true;
    bf16_t* O; int ldo; int col_base; const float* bias;
    DI void operator()(const f32x4 (&acc)[2][2][4][2], const Unit& u, int wr, int wc, int fr, int fq) const {
        const int row0 = u.pm * BM + wr * 64 + fr, c0 = u.pn * HALF + wc * 32 + 8 * fq;
#pragma unroll
        for (int ai = 0; ai < 2; ++ai)
#pragma unroll
            for (int m = 0; m < 4; ++m) {
                const f32x4 ba0 = *(const volatile f32x4*)(bias + c0), ba1 = *(const volatile f32x4*)(bias + c0 + 4), bg0 = *(const volatile f32x4*)(bias + 256 + c0), bg1 = *(const volatile f32x4*)(bias + 256 + c0 + 4);
                bf16_t* rowp = O + (size_t)(row0 + ai * HALF + m * 16) * ldo + col_base + c0;
                const f32x4 a0 = acc[ai][0][m][0] + ba0, a1 = acc[ai][0][m][1] + ba1, g0 = acc[ai][1][m][0] + bg0, g1 = acc[ai][1][m][1] + bg1;
                u32x4 w;
                w.x = pk2(a0[0] * sigmoid_f(g0[0]), a0[1] * sigmoid_f(g0[1])); w.y = pk2(a0[2] * sigmoid_f(g0[2]), a0[3] * sigmoid_f(g0[3]));
                w.z = pk2(a1[0] * sigmoid_f(g1[0]), a1[1] * sigmoid_f(g1[1])); w.w = pk2(a1[2] * sigmoid_f(g1[2]), a1[3] * sigmoid_f(g1[3]));
                *(u32x4*)rowp = w;
            }
    }
};
struct EpiResid {
    static constexpr bool PERM = false;
    const float* rin_x; const float* rin_c; float* rout_x; float* rout_c; const float* gate; float gs;
    DI void operator()(const f32x4 (&acc)[2][2][4][2], const Unit& u, int wr, int wc, int fr, int fq) const {
        const int trow = u.pm * BM; const bool isx = trow < TX;
        const int mb = isx ? (trow >> 11) : 8;
        const float* rin = isx ? rin_x + (size_t)trow * DM : rin_c + (size_t)(trow - TX) * DM;
        float* rout = isx ? rout_x + (size_t)trow * DM : rout_c + (size_t)(trow - TX) * DM;
        const int r0 = wr * 64 + fr, col0 = u.pn * BM + wc * 32 + 4 * fq;
        f32x4 gv[2][2];
#pragma unroll
        for (int bj = 0; bj < 2; ++bj)
#pragma unroll
            for (int n = 0; n < 2; ++n) gv[bj][n] = *(const f32x4*)(gate + (size_t)mb * 9216 + col0 + bj * HALF + n * 16) * gs;
#pragma unroll
        for (int ai = 0; ai < 2; ++ai)
#pragma unroll
            for (int m = 0; m < 4; ++m) {
                const size_t ro = (size_t)(r0 + ai * HALF + m * 16) * DM + col0;
#pragma unroll
                for (int bj = 0; bj < 2; ++bj)
#pragma unroll
                    for (int n = 0; n < 2; ++n) {
                        const f32x4 r = *(const f32x4*)(rin + ro + bj * HALF + n * 16);
                        *(f32x4*)(rout + ro + bj * HALF + n * 16) = r + gv[bj][n] * acc[ai][bj][m][n];
                    }
            }
    }
};
struct EpiResidAtomicC {
    static constexpr bool PERM = false;
    float* rout_c; const float* gate; float gs;
    DI void operator()(const f32x4 (&acc)[2][2][4][2], const Unit& u, int wr, int wc, int fr, int fq) const {
        float* rout = rout_c + (size_t)u.pm * BM * DM;
        const int r0 = wr * 64 + fr, col0 = u.pn * BM + wc * 32 + 4 * fq;
#pragma unroll
        for (int bj = 0; bj < 2; ++bj)
#pragma unroll
            for (int n = 0; n < 2; ++n) {
                const f32x4 gv = *(const f32x4*)(gate + (size_t)8 * 9216 + col0 + bj * HALF + n * 16) * gs;
#pragma unroll
                for (int ai = 0; ai < 2; ++ai)
#pragma unroll
                    for (int m = 0; m < 4; ++m) *(f32x4*)(rout + (size_t)(r0 + ai * HALF + m * 16) * DM + col0 + bj * HALF + n * 16) = gv * acc[ai][bj][m][n];
            }
    }
};
struct EpiStore {
    static constexpr bool PERM = true;
    bf16_t* O; int ldo; int rows_valid; int cols_valid; int kmap;
    DI void operator()(const f32x4 (&acc)[2][2][4][2], const Unit& u, int wr, int wc, int fr, int fq) const {
        const int row0 = u.pm * BM + wr * 64 + fr;
#pragma unroll
        for (int bj = 0; bj < 2; ++bj) {
            const int c = u.pn * BM + bj * HALF + wc * 32 + 8 * fq;
            if (c >= cols_valid) continue;
            const int cd = kmap ? (96 * (c >> 6) + (c & 63)) : c;
#pragma unroll
            for (int ai = 0; ai < 2; ++ai)
#pragma unroll
                for (int m = 0; m < 4; ++m) {
                    const int row = row0 + ai * HALF + m * 16;
                    if (row < rows_valid) {
                        const f32x4 v0 = acc[ai][bj][m][0], v1 = acc[ai][bj][m][1];
                        u32x4 w; w.x = pk2(v0[0], v0[1]); w.y = pk2(v0[2], v0[3]); w.z = pk2(v1[0], v1[1]); w.w = pk2(v1[2], v1[3]);
                        *(u32x4*)(O + (size_t)row * ldo + cd) = w;
                    }
                }
        }
    }
};
}

template <class Epi>
DI void gemm_call(LAS unsigned char* lds, const bf16_t* A, int lda, const bf16_t* Bt, int ldb, int M, int N, int K, const Epi& E, int coff) {
    pg8::Gemm g; g.A = A; g.Bt = Bt; g.lda = lda; g.ldb = ldb; g.M = M; g.N = N; g.K = K;
    pg8::StaticOrder S; S.init(M, N, (int)gridDim.x, (int)(((unsigned)obid() + (unsigned)coff) % gridDim.x));
    pg8::gemm_phase<Epi>(lds, g, S, E);
}


DI void transpose_item(const float* W, int K, int N, bf16_t* WT, int k0, int n0, int drow0, LAS float* scr, int lane) {
    f32x4 tv[8];
    const int kr = lane >> 3, n4 = (lane & 7) * 4;
#pragma unroll
    for (int i = 0; i < 8; ++i) tv[i] = *(const f32x4*)(W + (size_t)(k0 + 8 * i + kr) * N + n0 + n4);
#pragma unroll
    for (int i = 0; i < 8; ++i) { LAS float* d = scr + (8 * i + kr) * 33 + n4; d[0] = tv[i][0]; d[1] = tv[i][1]; d[2] = tv[i][2]; d[3] = tv[i][3]; }
    LDS_WAIT();
    const int c = lane & 7;
#pragma unroll
    for (int j = 0; j < 4; ++j) {
        const int n = (lane >> 3) + 8 * j; const LAS float* sp = scr + (8 * c) * 33 + n;
        u32x4 o; o.x = pk2(sp[0 * 33], sp[1 * 33]); o.y = pk2(sp[2 * 33], sp[3 * 33]); o.z = pk2(sp[4 * 33], sp[5 * 33]); o.w = pk2(sp[6 * 33], sp[7 * 33]);
        *(u32x4*)(WT + (size_t)(drow0 + n) * K + k0 + 8 * c) = o;
    }
    LDS_WAIT();
}
DI int gu_map(int n0, int half) { const int j = n0 < half ? n0 : n0 - half; return 256 * (j >> 7) + (n0 < half ? 0 : 128) + (j & 127); }
constexpr int I_GU = 2 * 16 * 176, I_DN = 2 * 44 * 32, I_IN = 16 * 65, I_OUT = 16 * 32, I_UQ = 6 * 18, I_UKV = 4 * 24, I_GLU = 4 * 16;
constexpr int I_L = I_GU + I_DN + I_IN + I_OUT + I_UQ + I_UKV + I_GLU;
constexpr int I_FIRST = 16 * 176;
DI void do_transposes(const Params& P, LAS unsigned char* lds, int first, int last, int widx, int nw) {
    const int tid_ = otid(); const int lane = tid_ & 63, wave = tid_ >> 6;
    unsigned char* ws = ows(P);
    LAS float* scr = (LAS float*)lds + wave * (64 * 33);
    for (int it = first + widx; it < last; it += nw) {
        const int l = it / I_L; int r = it % I_L;
        if (r < I_GU) { const int f = r / (16 * 176), q = r % (16 * 176), kb = q / 176, nb = q % 176, n0 = nb * 32;
            transpose_item(P.in[oidx(7)] + (size_t)(l * 2 + f) * 1024 * 5632, 1024, 5632, (bf16_t*)(ws + OFF_WGU) + (size_t)(l * 2 + f) * 5632 * 1024, kb * 64, n0, gu_map(n0, 2816), scr, lane); continue; }
        r -= I_GU;
        if (r < I_DN) { const int f = r / (44 * 32), q = r % (44 * 32), kb = q / 32, nb = q % 32;
            transpose_item(P.in[oidx(8)] + (size_t)(l * 2 + f) * 2816 * 1024, 2816, 1024, (bf16_t*)(ws + OFF_WDN) + (size_t)(l * 2 + f) * 1024 * 2816, kb * 64, nb * 32, nb * 32, scr, lane); continue; }
        r -= I_DN;
        if (r < I_IN) { const int kb = r / 65, nb = r % 65, n0 = nb * 32;
            bf16_t* dst; int drow;
            if (n0 < 768) { dst = (bf16_t*)(ws + OFF_WIN) + (size_t)l * NZ * 1024; drow = n0; }
            else if (n0 < 1152) { dst = (bf16_t*)(ws + OFF_WVA) + (size_t)l * 512 * 1024; drow = n0 - 768; }
            else { dst = (bf16_t*)(ws + OFF_WIN) + (size_t)l * NZ * 1024; drow = n0 - 384; }
            transpose_item(P.in[oidx(9)] + (size_t)l * 1024 * 2080, 1024, 2080, dst, kb * 64, n0, drow, scr, lane); continue; }
        r -= I_IN;
        if (r < I_OUT) { const int kb = r / 32, nb = r % 32;
            transpose_item(P.in[oidx(10)] + (size_t)l * 1024 * 1024, 1024, 1024, (bf16_t*)(ws + OFF_WOUT) + (size_t)l * 1024 * 1024, kb * 64, nb * 32, nb * 32, scr, lane); continue; }
        r -= I_OUT;
        if (r < I_UQ) { const int kb = r / 18, nb = r % 18;
            transpose_item(P.in[oidx(15)] + (size_t)l * 384 * 576, 384, 576, (bf16_t*)(ws + OFF_WUQ) + (size_t)l * 768 * 384, kb * 64, nb * 32, nb * 32, scr, lane); continue; }
        r -= I_UQ;
        if (r < I_UKV) { const int kb = r / 24, nb = r % 24, n0 = nb * 32, h = n0 >> 7, j = n0 & 127;
            bf16_t* dst = (j < 64) ? (bf16_t*)(ws + OFF_WUK) + (size_t)l * 512 * 256 : (bf16_t*)(ws + OFF_WUV) + (size_t)l * 512 * 256;
            transpose_item(P.in[oidx(16)] + (size_t)l * 256 * 768, 256, 768, dst, kb * 64, n0, 64 * h + (j & 63), scr, lane); continue; }
        r -= I_UKV;
        { const int kb = r / 16, nb = r % 16, n0 = nb * 32;
            transpose_item(P.in[oidx(26)] + (size_t)l * 256 * 512, 256, 512, (bf16_t*)(ws + OFF_WGLU) + (size_t)l * 512 * 256, kb * 64, n0, gu_map(n0, 256), scr, lane); }
    }
}

DI void s5_tables(const Params& P, int ldg, LAS unsigned char* lds, int tid);
DI void mods_units(const Params& P, LAS unsigned char* lds, int first, int last, int bidx, int nb);
DI void deferred_transposes(const Params& P, LAS unsigned char* lds, int slot, int first_idle) {
    const int c = obid(); if (c < first_idle || slot > 3) return;
    if (slot == 2) mods_units(P, lds, 144, 288, c - first_idle, 256 - first_idle);
    __syncthreads();
    const int nw = (256 - first_idle) * 8, widx = (c - first_idle) * 8 + (otid() >> 6);
    if (slot == 0) { do_transposes(P, lds, 5632, 7040, widx, nw); do_transposes(P, lds, 8448, I_L, widx, nw); }
    else if (slot == 1) { do_transposes(P, lds, 2816, 5632, widx, nw); do_transposes(P, lds, 7040, 8448, widx, nw); }
    else if (slot == 2) { do_transposes(P, lds, I_L + 0, I_L + 2816, widx, nw); do_transposes(P, lds, I_L + 5632, I_L + 7040, widx, nw); do_transposes(P, lds, I_L + 8448, 2 * I_L, widx, nw); }
    else { do_transposes(P, lds, I_L + 2816, I_L + 5632, widx, nw); do_transposes(P, lds, I_L + 7040, I_L + 8448, widx, nw); }
}
DI void s5_tables(const Params& P, int ldg, LAS unsigned char* lds, int tid);
DI void mods_units(const Params& P, LAS unsigned char* lds, int first, int last, int bidx, int nb) {
    const int tid = otid(), lane = tid & 63, wave = tid >> 6;
    unsigned char* ws = ows(P);
    LAS float* sv = (LAS float*)lds; LAS float* red = sv + 9 * 1024;
    __syncthreads();
    for (int i = tid; i < 9 * 1024; i += 512) { const int mb = i >> 10, k = i & 1023; const float c = mb < 8 ? P.in[oidx(1)][mb * 1024 + k] : P.in[oidx(3)][k]; sv[i] = c / (1.f + expf(-c)); }
    __syncthreads();
    float* mods = (float*)(ws + OFF_MODS);
    for (int u = first + bidx; u < last; u += nb) {
        const int l = u / 144, cgp = u % 144, kq = lane >> 4, c4 = (lane & 15) * 4;
        const float* W = P.in[oidx(4)] + (size_t)l * 1024 * 9216 + cgp * 64 + c4;
        f32x4 a[9];
#pragma unroll
        for (int mb = 0; mb < 9; ++mb) a[mb] = (f32x4){0.f, 0.f, 0.f, 0.f};
        for (int i0 = 0; i0 < 32; i0 += 8) {
            f32x4 w8[8];
#pragma unroll
            for (int i = 0; i < 8; ++i) w8[i] = *(const f32x4*)(W + (size_t)(wave * 128 + 4 * (i0 + i) + kq) * 9216);
#pragma unroll
            for (int i = 0; i < 8; ++i) { const int k = wave * 128 + 4 * (i0 + i) + kq;
#pragma unroll
                for (int mb = 0; mb < 9; ++mb) a[mb] += w8[i] * sv[mb * 1024 + k]; }
        }
#pragma unroll
        for (int mb = 0; mb < 9; ++mb) *(LAS f32x4*)(red + ((wave * 4 + kq) * 9 + mb) * 64 + c4) = a[mb];
        __syncthreads();
        for (int i = tid; i < 576; i += 512) {
            const int mb = i >> 6, cc = i & 63; float sum = 0.f;
#pragma unroll
            for (int k32 = 0; k32 < 32; ++k32) sum += red[(k32 * 9 + mb) * 64 + cc];
            mods[(size_t)(l * 9 + mb) * 9216 + cgp * 64 + cc] = sum + P.in[oidx(5)][l * 9216 + cgp * 64 + cc];
        }
        __syncthreads();
    }
    __syncthreads();
}
DI void phase_prep(const Params& P, LAS unsigned char* lds) {
    const int tid = otid(), wave = tid >> 6, G = gridDim.x, bid = obid();
    unsigned char* ws = ows(P);
    mods_units(P, lds, 0, 144, bid, G);
    { const f32x4* src = (const f32x4*)P.in[oidx(2)]; f32x4* dst = (f32x4*)(ws + OFF_HXC); for (int i = bid * 512 + tid; i < TC * DM / 4; i += G * 512) dst[i] = src[i]; }
    const int gtid = bid * 512 + tid;
    if (gtid < 512) { const int pos = gtid >> 3, i = gtid & 7; const float inv = exp2f(-(float)i * 0.125f * 13.287712379549449f); const float ang = (float)pos * inv;
        float* rt = (float*)(ws + OFF_ROPE); rt[gtid * 2] = cosf(ang); rt[gtid * 2 + 1] = sinf(ang); }
    for (int it = (bid + G - 144) % G; it < 64; it += G) s5_tables(P, it, lds, tid);
    __syncthreads();
    do_transposes(P, lds, 0, I_FIRST, bid * 8 + wave, G * 8);
}

DI void phase_modulate(const float* src_x, float* src_c, int nrows, const float* g, const float* shift, const float* scale, bf16_t* A, const float* slab) {
    const int tid_ = otid(); const int lane = tid_ & 63, gw = obid() * 8 + (tid_ >> 6), NGW = gridDim.x * 8;
    for (int row = gw; row < nrows; row += NGW) {
        const float* xr = row < TX ? src_x + (size_t)row * DM : src_c + (size_t)(row - TX) * DM;
        const int mb = row < TX ? (row >> 11) : 8;
        f32x4 v[4]; float ss = 0.f;
#pragma unroll
        for (int j = 0; j < 4; ++j) v[j] = *(const f32x4*)(xr + 4 * lane + 256 * j);
        if (slab != nullptr && row >= TX) {
            const float* s0 = slab + (size_t)(row - TX) * DM; float* hw = src_c + (size_t)(row - TX) * DM;
#pragma unroll
            for (int j = 0; j < 4; ++j) { v[j] += (*(const f32x4*)(s0 + 4 * lane + 256 * j) + *(const f32x4*)(s0 + (size_t)TC * DM + 4 * lane + 256 * j))
                                              + (*(const f32x4*)(s0 + (size_t)2 * TC * DM + 4 * lane + 256 * j) + *(const f32x4*)(s0 + (size_t)3 * TC * DM + 4 * lane + 256 * j)); *(f32x4*)(hw + 4 * lane + 256 * j) = v[j]; }
        }
#pragma unroll
        for (int j = 0; j < 4; ++j) ss += v[j].x * v[j].x + v[j].y * v[j].y + v[j].z * v[j].z + v[j].w * v[j].w;
        const float r = 1.f / sqrtf(wave_sum(ss, lane) * (1.f / DM) + EPSN);
#pragma unroll
        for (int j = 0; j < 4; ++j) {
            const int c = 4 * lane + 256 * j;
            const f32x4 gg = *(const f32x4*)(g + c), sh = *(const f32x4*)(shift + (size_t)mb * 9216 + c), sc = *(const f32x4*)(scale + (size_t)mb * 9216 + c);
            const f32x4 y = v[j] * r * gg * (sc + 1.f) + sh;
            u32x2 w; w.x = pk2(y.x, y.y); w.y = pk2(y.z, y.w);
            *(u32x2*)(A + (size_t)row * DM + c) = w;
        }
    }
}

DI void phase_znorm(const Params& P, int l) {
    const int tid_ = otid(); const int lane = tid_ & 63, gw = obid() * 8 + (tid_ >> 6), NGW = gridDim.x * 8;
    bf16_t* z = (bf16_t*)(ows(P) + OFF_Z);
    const float* gq = P.in[oidx(11)] + l * 128; const float* gk = gq + 64;
    const float* gcq = P.in[oidx(13)] + l * 384; const float* gckv = P.in[oidx(14)] + l * 256;
    const float qs = 0.125f * LOG2E;
    for (int row = gw; row < TT; row += NGW) {
        bf16_t* zr = z + (size_t)row * NZ;
        const bool a48 = lane < 48, a32 = lane < 32;
        u32x4 wq = {0, 0, 0, 0}, wk = {0, 0, 0, 0}, wc = {0, 0, 0, 0}, wv = {0, 0, 0, 0};
        if (a48) { wq = *(const u32x4*)(zr + ZQA + 8 * lane); wk = *(const u32x4*)(zr + ZKA + 8 * lane); wc = *(const u32x4*)(zr + ZCQ + 8 * lane); }
        if (a32) wv = *(const u32x4*)(zr + ZCKV + 8 * lane);
        float fq[8], fk[8], fc[8], fv[8]; unpack8(wq, fq); unpack8(wk, fk); unpack8(wc, fc); unpack8(wv, fv);
        float sq = 0, sk = 0, sc = 0, sv = 0;
#pragma unroll
        for (int i = 0; i < 8; ++i) { sq += fq[i] * fq[i]; sk += fk[i] * fk[i]; sc += fc[i] * fc[i]; sv += fv[i] * fv[i]; }
#pragma unroll
        for (int o = 1; o < 8; o <<= 1) { sq += shx(sq, o, lane); sk += shx(sk, o, lane); }
        sc = wave_sum(sc, lane); sv = wave_sum(sv, lane);
        const float rq = qs / sqrtf(sq * (1.f / 64.f) + EPSN), rk = 1.f / sqrtf(sk * (1.f / 64.f) + EPSN);
        const float rc = 1.f / sqrtf(sc * (1.f / 384.f) + EPSN), rv = 1.f / sqrtf(sv * (1.f / 256.f) + EPSN);
        const int hc = (8 * lane) & 63;
        if (a48) {
#pragma unroll
            for (int i = 0; i < 8; ++i) { fq[i] *= rq * gq[hc + i]; fk[i] *= rk * gk[hc + i]; fc[i] *= rc * gcq[8 * lane + i]; }
            *(u32x4*)(zr + ZQA + 8 * lane) = pack8(fq); *(u32x4*)(zr + ZKA + 8 * lane) = pack8(fk); *(u32x4*)(zr + ZCQ + 8 * lane) = pack8(fc);
        }
        if (a32) {
#pragma unroll
            for (int i = 0; i < 8; ++i) fv[i] *= rv * gckv[8 * lane + i];
            *(u32x4*)(zr + ZCKV + 8 * lane) = pack8(fv);
        }
    }
}

DI void phase_finish(const Params& P, int l) {
    const int tid_ = otid(); const int lane = tid_ & 63, gw = obid() * 8 + (tid_ >> 6), NGW = gridDim.x * 8;
    bf16_t* Qm = (bf16_t*)(ows(P) + OFF_QM); bf16_t* Km = (bf16_t*)(ows(P) + OFF_KM); const bf16_t* z = (const bf16_t*)(ows(P) + OFF_Z);
    const float* gq = P.in[oidx(17)] + l * 192; const float* gk = gq + 96;
    const float* rope = (const float*)(ows(P) + OFF_ROPE);
    const float qs = 0.10206207261596575f * LOG2E;
    const int hq = lane >> 4, ch = lane & 15;
    for (int row = gw; row < TT; row += NGW) {
        const bool lat = row < TX; const int n = row & 2047; const int pos = (ch < 10) ? (n >> 6) : (n & 63);
        const bool doq = lat || l == 0;
#pragma unroll
        for (int pass = 0; pass < 2; ++pass) {
            const int head = 4 * pass + hq; const bool act = (head < 6) && (ch < 12);
            u32x4 wq = {0, 0, 0, 0}, wk = {0, 0, 0, 0};
            if (act) {
                if (doq) wq = *(const u32x4*)(Qm + (size_t)row * 576 + head * 96 + 8 * ch);
                if (ch < 8) wk = *(const u32x4*)(Km + (size_t)row * 576 + head * 96 + 8 * ch);
                else wk = *(const u32x4*)(z + (size_t)row * NZ + ZKR + 8 * (ch - 8));
            }
            float fq[8], fk[8]; unpack8(wq, fq); unpack8(wk, fk);
            float sq = 0, sk = 0;
#pragma unroll
            for (int i = 0; i < 8; ++i) { sq += fq[i] * fq[i]; sk += fk[i] * fk[i]; }
#pragma unroll
            for (int o = 1; o < 16; o <<= 1) { sq += shx(sq, o, lane); sk += shx(sk, o, lane); }
            const float rq = 1.f / sqrtf(sq * (1.f / 96.f) + EPSN), rk = 1.f / sqrtf(sk * (1.f / 96.f) + EPSN);
            const int cch = ch < 12 ? ch : 0;
#pragma unroll
            for (int i = 0; i < 8; ++i) { fq[i] *= rq * gq[8 * cch + i]; fk[i] *= rk * gk[8 * cch + i]; }
#pragma unroll
            for (int i = 0; i < 8; ++i) {
                const float pq = shx(fq[i], 1, lane), pk = shx(fk[i], 1, lane);
                if (lat && ch >= 8 && ch < 12) {
                    const float c = rope[(pos * 8 + i) * 2], s = rope[(pos * 8 + i) * 2 + 1];
                    const float sg = (ch & 1) ? s : -s;
                    fq[i] = fq[i] * c + pq * sg; fk[i] = fk[i] * c + pk * sg;
                }
            }
            if (act) {
                if (doq) {
#pragma unroll
                    for (int i = 0; i < 8; ++i) fq[i] *= qs;
                    *(u32x4*)(Qm + (size_t)row * 576 + head * 96 + 8 * ch) = pack8(fq);
                }
                *(u32x4*)(Km + (size_t)row * 576 + head * 96 + 8 * ch) = pack8(fk);
            }
        }
    }
}

DI int s5_tok_row(int b, int cc, int s) { return cc < 16 ? TX + b * 256 + cc * 16 + s : b * 2048 + (cc - 16) * 16 + s; }
DI void s5_tables(const Params& P, int ldg, LAS unsigned char* lds, int tid) {
    LAS f32x2* pw = (LAS f32x2*)lds;
    LAS f32x2* bb = pw + 17 * 64;
    LAS f32x2* cc = bb + 64 * 16;
    LAS float* T = (LAS float*)(cc + 16 * 64);
    const int d = (ldg >> 4) & 1;
    unsigned char* ws = ows(P);
    if (tid < 64) {
        const int i = ldg * 64 + tid;
        const float lre = P.in[oidx(18)][i], lim = P.in[oidx(19)][i], dt = expf(P.in[oidx(20)][ldg]);
        const float er = expf(lre * dt), ang = lim * dt; const float lbr = er * cosf(ang), lbi = er * sinf(ang);
        const float nr = lbr - 1.f, ni = lbi, den = lre * lre + lim * lim;
        const float qr = (nr * lre + ni * lim) / den, qi = (ni * lre - nr * lim) / den;
        float wr = 1.f, wi = 0.f;
        for (int j = 0; j <= 16; ++j) { pw[j * 64 + tid] = (f32x2){wr, wi}; const float t = wr * lbr - wi * lbi; wi = wr * lbi + wi * lbr; wr = t; }
        ((f32x2*)(ws + OFF_S5L16))[i] = pw[16 * 64 + tid];
        for (int m = 0; m < 16; ++m) { const float br = P.in[oidx(21)][(size_t)i * 16 + m], bi = P.in[oidx(22)][(size_t)i * 16 + m]; bb[tid * 16 + m] = (f32x2){qr * br - qi * bi, qr * bi + qi * br}; }
    }
    for (int e = tid; e < 1024; e += 512) cc[e] = (f32x2){P.in[oidx(23)][(size_t)ldg * 1024 + e], P.in[oidx(24)][(size_t)ldg * 1024 + e]};
    __syncthreads();
    {
        const int m = (tid >> 4) & 15, mp = tid & 15, j0 = tid >> 8;
        float acc[8];
#pragma unroll
        for (int i = 0; i < 8; ++i) acc[i] = 0.f;
        for (int p = 0; p < 64; ++p) {
            const f32x2 c = cc[m * 64 + p], b = bb[p * 16 + mp];
            const float cbr = c.x * b.x - c.y * b.y, cbi = c.x * b.y + c.y * b.x;
#pragma unroll
            for (int i = 0; i < 8; ++i) { const f32x2 w = pw[(j0 + 2 * i) * 64 + p]; acc[i] += cbr * w.x - cbi * w.y; }
        }
#pragma unroll
        for (int i = 0; i < 8; ++i) T[((j0 + 2 * i) * 16 + m) * 16 + mp] = acc[i];
    }
    __syncthreads();
    bf16_t* Km = (bf16_t*)(ws + OFF_S5K) + (size_t)ldg * 65536;
    for (int ch = tid; ch < 8192; ch += 512) {
        const int row = ch >> 5, c0 = (ch & 31) * 8, t = row >> 4, m = row & 15, sx = c0 >> 4, mp0 = c0 & 15;
        const int lag = d == 0 ? t - sx : sx - t; float v[8];
#pragma unroll
        for (int i = 0; i < 8; ++i) v[i] = lag >= 0 ? T[(lag * 16 + m) * 16 + mp0 + i] : 0.f;
        *(u32x4*)(Km + (size_t)row * 256 + c0) = pack8(v);
    }
    bf16_t* Em = (bf16_t*)(ws + OFF_S5E) + (size_t)ldg * 32768;
    for (int ch = tid; ch < 4096; ch += 512) {
        const int row = ch >> 5, c0 = (ch & 31) * 8, p = row >> 1, c = row & 1, sx = c0 >> 4, mp0 = c0 & 15;
        const f32x2 w = pw[(d == 0 ? 15 - sx : sx) * 64 + p]; float v[8];
#pragma unroll
        for (int i = 0; i < 8; ++i) { const f32x2 b = bb[p * 16 + mp0 + i]; v[i] = c ? (w.x * b.y + w.y * b.x) : (w.x * b.x - w.y * b.y); }
        *(u32x4*)(Em + (size_t)row * 256 + c0) = pack8(v);
    }
    bf16_t* Fm = (bf16_t*)(ws + OFF_S5F) + (size_t)ldg * 32768;
    for (int ch = tid; ch < 4096; ch += 512) {
        const int row = ch >> 4, c0 = (ch & 15) * 8, t = row >> 4, m = row & 15, p0 = c0 >> 1; float v[8];
#pragma unroll
        for (int i = 0; i < 4; ++i) { const f32x2 w = pw[(d == 0 ? t + 1 : 16 - t) * 64 + p0 + i], c = cc[m * 64 + p0 + i];
            v[2 * i] = c.x * w.x - c.y * w.y; v[2 * i + 1] = -(c.x * w.y + c.y * w.x); }
        *(u32x4*)(Fm + (size_t)row * 128 + c0) = pack8(v);
    }
    __syncthreads();
}
DI void phase_s5_s1(const Params& P, int l) {
    const int tid_ = otid(); const int lane = tid_ & 63, fr = lane & 15, fq = lane >> 4, gw = (tid_ >> 6) * (int)gridDim.x + obid(), NGW = gridDim.x * 8;
    const bf16_t* z = (const bf16_t*)(ows(P) + OFF_Z);
    float* se = (float*)(ows(P) + OFF_SE);
    for (int it = gw; it < 2304; it += NGW) {
        const int cb = it % 72, gd = it / 72, d = gd & 1, g = gd >> 1, b = cb / 9, cc = 16 * (cb % 9) + fr;
        const bf16_t* Em = (const bf16_t*)(ows(P) + OFF_S5E) + (size_t)((l * 2 + d) * 16 + g) * 32768;
        bf16x8 uf[8];
#pragma unroll
        for (int ks = 0; ks < 8; ++ks) uf[ks] = *(const bf16x8*)(z + (size_t)s5_tok_row(b, cc, 2 * ks + (fq >> 1)) * NZ + ZU + 16 * g + 8 * (fq & 1));
        float* so = se + ((size_t)(((b * 16 + g) * 2 + d) * 144 + cc)) * 128 + 4 * fq;
#pragma unroll
        for (int rb = 0; rb < 8; ++rb) {
            bf16x8 a[8];
#pragma unroll
            for (int ks = 0; ks < 8; ++ks) a[ks] = *(const bf16x8*)(Em + (size_t)(rb * 16 + fr) * 256 + 32 * ks + 8 * fq);
            __builtin_amdgcn_sched_barrier(0);
            f32x4 acc = {0.f, 0.f, 0.f, 0.f};
#pragma unroll
            for (int ks = 0; ks < 8; ++ks) acc = __builtin_amdgcn_mfma_f32_16x16x32_bf16(a[ks], uf[ks], acc, 0, 0, 0);
            *(f32x4*)(so + 16 * rb) = acc;
            __builtin_amdgcn_sched_barrier(0);
        }
    }
}
DI void phase_s5_s2(const Params& P, int l, LAS unsigned char* lds) {
    const int tid_ = otid(); const int lane = tid_ & 63, wave = __builtin_amdgcn_readfirstlane(tid_ >> 6);
    const float* se = (const float*)(ows(P) + OFF_SE); bf16_t* hs = (bf16_t*)(ows(P) + OFF_SH);
    LAS f32x2* seg = (LAS f32x2*)lds;
    for (int line = obid(); line < 256; line += (int)gridDim.x) {
        const int d = line & 1, g = (line >> 1) & 15;
        const f32x2 lam = ((const f32x2*)(ows(P) + OFF_S5L16))[((l * 2 + d) * 16 + g) * 64 + lane];
        const float* sl = se + (size_t)line * 144 * 128 + 2 * lane; bf16_t* hl = hs + (size_t)line * 144 * 128 + 2 * lane;
        f32x2 ev[18];
#pragma unroll
        for (int i = 0; i < 18; ++i) { const int j = wave * 18 + i; const int cc = d == 0 ? j : (j < 16 ? 15 - j : 159 - j); ev[i] = *(const f32x2*)(sl + cc * 128); }
        float br = 0.f, bi = 0.f, ar = 1.f, ai = 0.f;
#pragma unroll
        for (int i = 0; i < 18; ++i) {
            const float nr = lam.x * br - lam.y * bi + ev[i].x, ni = lam.x * bi + lam.y * br + ev[i].y; br = nr; bi = ni;
            const float tr = lam.x * ar - lam.y * ai, ti = lam.x * ai + lam.y * ar; ar = tr; ai = ti;
        }
        seg[wave * 64 + lane] = (f32x2){br, bi};
        __syncthreads();
        float hr = 0.f, hi = 0.f;
        for (int sgi = 0; sgi < wave; ++sgi) { const f32x2 b2 = seg[sgi * 64 + lane]; const float nr = ar * hr - ai * hi + b2.x, ni = ar * hi + ai * hr + b2.y; hr = nr; hi = ni; }
#pragma unroll
        for (int i = 0; i < 18; ++i) {
            const int j = wave * 18 + i; const int cc = d == 0 ? j : (j < 16 ? 15 - j : 159 - j);
            *(unsigned*)(hl + cc * 128) = pk2(hr, hi);
            const float nr = lam.x * hr - lam.y * hi + ev[i].x, ni = lam.x * hi + lam.y * hr + ev[i].y; hr = nr; hi = ni;
        }
        __syncthreads();
    }
}
DI void phase_s5_s3(const Params& P, int l) {
    const int tid_ = otid(); const int lane = tid_ & 63, fr = lane & 15, fq = lane >> 4, gw = (tid_ >> 6) * (int)gridDim.x + obid(), NGW = gridDim.x * 8;
    const bf16_t* z = (const bf16_t*)(ows(P) + OFF_Z); const bf16_t* hs = (const bf16_t*)(ows(P) + OFF_SH); bf16_t* yb = (bf16_t*)(ows(P) + OFF_YB);
    for (int it = gw; it < 1152; it += NGW) {
        const int cbl = it % 9, b = (it / 9) & 7, g = it / 72;
        if (l == 1 && cbl == 0) continue;
        const int cc = 16 * cbl + fr;
        bf16x8 uf[8];
#pragma unroll
        for (int ks = 0; ks < 8; ++ks) uf[ks] = *(const bf16x8*)(z + (size_t)s5_tok_row(b, cc, 2 * ks + (fq >> 1)) * NZ + ZU + 16 * g + 8 * (fq & 1));
        f32x4 y[16];
#pragma unroll
        for (int t = 0; t < 16; ++t) y[t] = (f32x4){0.f, 0.f, 0.f, 0.f};
        const int ldg0 = (l * 2 + 0) * 16 + g;
        const bf16_t* Km0 = (const bf16_t*)(ows(P) + OFF_S5K) + (size_t)ldg0 * 65536 + (size_t)fr * 256 + 8 * fq;
        const bf16_t* Fm0 = (const bf16_t*)(ows(P) + OFF_S5F) + (size_t)ldg0 * 32768 + (size_t)fr * 128 + 8 * fq;
        const bf16_t* hp0 = hs + ((size_t)(((b * 16 + g) * 2 + 0) * 144 + cc)) * 128 + 8 * fq;
        bf16x8 hf[2][4];
#pragma unroll
        for (int d = 0; d < 2; ++d)
#pragma unroll
            for (int ks = 0; ks < 4; ++ks) hf[d][ks] = *(const bf16x8*)(hp0 + (size_t)d * 144 * 128 + 32 * ks);
#pragma unroll
        for (int t = 0; t < 16; ++t) {
            bf16x8 a[24]; int n = 0;
#pragma unroll
            for (int d = 0; d < 2; ++d) {
#pragma unroll
                for (int ks = 0; ks < 8; ++ks) if (d == 0 ? (2 * ks <= t) : (2 * ks + 1 >= t)) a[n++] = *(const bf16x8*)(Km0 + (size_t)d * 16 * 65536 + (size_t)t * 16 * 256 + 32 * ks);
#pragma unroll
                for (int ks = 0; ks < 4; ++ks) a[n++] = *(const bf16x8*)(Fm0 + (size_t)d * 16 * 32768 + (size_t)t * 16 * 128 + 32 * ks);
            }
            __builtin_amdgcn_sched_barrier(0);
            n = 0;
#pragma unroll
            for (int d = 0; d < 2; ++d) {
#pragma unroll
                for (int ks = 0; ks < 8; ++ks) if (d == 0 ? (2 * ks <= t) : (2 * ks + 1 >= t)) y[t] = __builtin_amdgcn_mfma_f32_16x16x32_bf16(a[n++], uf[ks], y[t], 0, 0, 0);
#pragma unroll
                for (int ks = 0; ks < 4; ++ks) y[t] = __builtin_amdgcn_mfma_f32_16x16x32_bf16(a[n++], hf[d][ks], y[t], 0, 0, 0);
            }
            __builtin_amdgcn_sched_barrier(0);
        }
        const f32x4 dv = *(const f32x4*)(P.in[oidx(25)] + l * 256 + 16 * g + 4 * fq);
#pragma unroll
        for (int t = 0; t < 16; ++t) {
            const size_t row = (size_t)s5_tok_row(b, cc, t);
            const u32x2 uw = *(const u32x2*)(z + row * NZ + ZU + 16 * g + 4 * fq);
            const f32x4 u = {bflo(uw.x), bfhi(uw.x), bflo(uw.y), bfhi(uw.y)};
            const f32x4 v = y[t] + dv * u;
            u32x2 w; w.x = pk2(gelu_tanh_f(v.x), gelu_tanh_f(v.y)); w.y = pk2(gelu_tanh_f(v.z), gelu_tanh_f(v.w));
            *(u32x2*)(yb + row * 256 + 16 * g + 4 * fq) = w;
        }
    }
}

template <int DQK, int MODE>
DI void attn_item(const Params& P, int l, int b, int h, int qb, LAS unsigned char* lds) {
    constexpr int KSTR = DQK * 2 + 16, NKS = DQK / 16, KCH = DQK / 8;
    constexpr int KBUF = 64 * 208, VS_OFF = 2 * KBUF, VSTR = 136, VBUF = 64 * 136, RPB_OFF = VS_OFF + 2 * VBUF;
    const int tid = otid(), wave = __builtin_amdgcn_readfirstlane(tid >> 6), lane = tid & 63, q = lane & 31, hh = lane >> 5;
    const bf16_t* Qg; const bf16_t* Kg; const bf16_t* Vt; int ldq, ldk, ocol;
    if (DQK == 96) { Qg = (const bf16_t*)(ows(P) + OFF_QM) + h * 96; ldq = 576; Kg = (const bf16_t*)(ows(P) + OFF_KM) + h * 96; ldk = 576; Vt = (const bf16_t*)(ows(P) + OFF_VTM) + (size_t)h * 64 * TT; ocol = 384 + h * 64; }
    else { Qg = (const bf16_t*)(ows(P) + OFF_Z) + ZQA + h * 64; ldq = NZ; Kg = (const bf16_t*)(ows(P) + OFF_Z) + ZKA + h * 64; ldk = NZ; Vt = (const bf16_t*)(ows(P) + OFF_VTA) + (size_t)h * 64 * TT; ocol = h * 64; }
    int qrow0, ntiles, rmin = 0, rq = 0, rs = 0;
    if (MODE == 0) { qrow0 = b * 2048 + 256 * qb + 32 * wave; ntiles = 36; }
    else if (MODE == 1) { rq = 4 * qb + (wave >> 1); qrow0 = b * 2048 + 64 * rq + 32 * (wave & 1);
        rmin = min(max(4 * qb - 4, 0), 24); const int rmax = min(max(4 * qb + 3 - 4, 0), 24) + 7; ntiles = 4 + (rmax - rmin + 1); rs = min(max(rq - 4, 0), 24); }
    else { qrow0 = TX + b * 256 + 32 * wave; ntiles = oidx(4); }
    if (MODE == 1) {
        const float* rp = P.in[oidx(12)] + (size_t)(l * 6 + h) * 465;
        for (int i = tid; i < 465; i += 512) ((LAS float*)(lds + RPB_OFF))[i] = rp[i] * LOG2E;
    }
    bf16x8 bq[NKS];
    { const bf16_t* qp = Qg + (size_t)(qrow0 + q) * ldq + 8 * hh;
#pragma unroll
      for (int ks = 0; ks < NKS; ++ks) bq[ks] = *(const bf16x8*)(qp + 16 * ks); }
    f32x16 O0, O1;
#pragma unroll
    for (int i = 0; i < 16; ++i) { O0[i] = 0.f; O1[i] = 0.f; }
    float lsum = 0.f;
    const int cq = 32 * (wave & 1) + q, cs = min(max(cq - 8, 0), 48);
    auto tile_row = [&](int i) -> int { if (i < 4) return TX + b * 256 + 64 * i; if (MODE == 1) return b * 2048 + 64 * (rmin + i - 4); return b * 2048 + 64 * (i - 4); };
    u32x4 pkA0, pkA1 = {0, 0, 0, 0}, pvA, pkB0, pkB1 = {0, 0, 0, 0}, pvB;
    auto prefetch = [&](int i, u32x4& pk0, u32x4& pk1, u32x4& pv) {
        const int r0 = tile_row(i);
        { const int c = tid, row = c / KCH, cc = c % KCH; pk0 = *(const u32x4*)(Kg + (size_t)(r0 + row) * ldk + 8 * cc); }
        if (DQK == 96) { const int c = tid + 512; if (c < 64 * KCH) { const int row = c / KCH, cc = c % KCH; pk1 = *(const u32x4*)(Kg + (size_t)(r0 + row) * ldk + 8 * cc); } }
        { const int dv = tid >> 3, cc = tid & 7; pv = *(const u32x4*)(Vt + (size_t)dv * TT + r0 + 8 * cc); }
    };
    auto stage = [&](int buf, const u32x4& pk0, const u32x4& pk1, const u32x4& pv) {
        LAS unsigned char* kb_ = lds + buf * KBUF; LAS unsigned char* vb_ = lds + VS_OFF + buf * VBUF;
        { const int c = tid, row = c / KCH, cc = c % KCH; *(LAS u32x4*)(kb_ + row * KSTR + 16 * cc) = pk0; }
        if (DQK == 96) { const int c = tid + 512; if (c < 64 * KCH) { const int row = c / KCH, cc = c % KCH; *(LAS u32x4*)(kb_ + row * KSTR + 16 * cc) = pk1; } }
        { const int dv = tid >> 3, cc = tid & 7; LAS u32x2* vp = (LAS u32x2*)(vb_ + dv * VSTR + 16 * cc); vp[0] = (u32x2){pv.x, pv.y}; vp[1] = (u32x2){pv.z, pv.w}; }
    };
    auto compute = [&](int i, int buf) {
        const LAS unsigned char* kl = lds + buf * KBUF; const LAS unsigned char* vl = lds + VS_OFF + buf * VBUF;
        bool active = true; int kr = 0;
        if (MODE == 1 && i >= 4) { kr = rmin + i - 4; active = (kr >= rs) && (kr < rs + 8); }
        if (!active) return;
        f32x16 s0, s1;
#pragma unroll
        for (int j = 0; j < 16; ++j) { s0[j] = 0.f; s1[j] = 0.f; }
        {
            constexpr int HK = 2;
#pragma unroll
            for (int hf = 0; hf < NKS / 2; ++hf) {
                bf16x8 ka0[HK], ka1[HK];
#pragma unroll
                for (int k2 = 0; k2 < HK; ++k2) { const int ks = hf * HK + k2; ka0[k2] = *(const LAS bf16x8*)(kl + q * KSTR + 32 * ks + 16 * hh); ka1[k2] = *(const LAS bf16x8*)(kl + (32 + q) * KSTR + 32 * ks + 16 * hh); }
                __builtin_amdgcn_sched_barrier(0);
#pragma unroll
                for (int k2 = 0; k2 < HK; ++k2) { const int ks = hf * HK + k2;
                    s0 = __builtin_amdgcn_mfma_f32_32x32x16_bf16(ka0[k2], bq[ks], s0, 0, 0, 0);
                    s1 = __builtin_amdgcn_mfma_f32_32x32x16_bf16(ka1[k2], bq[ks], s1, 0, 0, 0); }
                __builtin_amdgcn_sched_barrier(0);
            }
        }
        s16x4 vlo[2][2][2], vhi[2][2][2];
#pragma unroll
        for (int sp = 0; sp < 2; ++sp)
#pragma unroll
            for (int dvb = 0; dvb < 2; ++dvb) {
                const int off = (32 * dvb + q) * VSTR + (16 * sp + 4 * hh) * 2;
                vlo[0][sp][dvb] = *(const LAS s16x4*)(vl + off); vhi[0][sp][dvb] = *(const LAS s16x4*)(vl + off + 16);
            }
        __builtin_amdgcn_sched_barrier(0);
        if (MODE == 1 && i >= 4) {
            const LAS float* rb = (const LAS float*)(lds + RPB_OFF) + (kr - rq + 7) * 31;
#pragma unroll
            for (int j = 0; j < 16; ++j) {
                const int kc0 = (j & 3) + 8 * (j >> 2) + 4 * hh, kc1 = kc0 + 32;
                const int i0 = min(max(kc0 - cq + 15, 0), 30), i1 = min(max(kc1 - cq + 15, 0), 30);
                const float b0 = rb[i0], b1 = rb[i1];
                s0[j] = (kc0 >= cs && kc0 < cs + 16) ? s0[j] + b0 : -1e30f;
                s1[j] = (kc1 >= cs && kc1 < cs + 16) ? s1[j] + b1 : -1e30f;
            }
        }
        float ps = 0.f;
#pragma unroll
        for (int j = 0; j < 16; ++j) { s0[j] = fast_exp2(s0[j]); s1[j] = fast_exp2(s1[j]); ps += s0[j] + s1[j]; }
        lsum += ps;
        bf16x8 bp[2][2];
#pragma unroll
        for (int sp = 0; sp < 2; ++sp) {
            u32x4 pw;
            pw.x = pk2(s0[8 * sp + 0], s0[8 * sp + 1]); pw.y = pk2(s0[8 * sp + 2], s0[8 * sp + 3]); pw.z = pk2(s0[8 * sp + 4], s0[8 * sp + 5]); pw.w = pk2(s0[8 * sp + 6], s0[8 * sp + 7]);
            bp[0][sp] = __builtin_bit_cast(bf16x8, pw);
            pw.x = pk2(s1[8 * sp + 0], s1[8 * sp + 1]); pw.y = pk2(s1[8 * sp + 2], s1[8 * sp + 3]); pw.z = pk2(s1[8 * sp + 4], s1[8 * sp + 5]); pw.w = pk2(s1[8 * sp + 6], s1[8 * sp + 7]);
            bp[1][sp] = __builtin_bit_cast(bf16x8, pw);
        }
        __builtin_amdgcn_sched_barrier(0);
#pragma unroll
        for (int sp = 0; sp < 2; ++sp)
#pragma unroll
            for (int dvb = 0; dvb < 2; ++dvb) {
                const int off = (32 * dvb + q) * VSTR + (32 + 16 * sp + 4 * hh) * 2;
                vlo[1][sp][dvb] = *(const LAS s16x4*)(vl + off); vhi[1][sp][dvb] = *(const LAS s16x4*)(vl + off + 16);
            }
        __builtin_amdgcn_sched_barrier(0);
#pragma unroll
        for (int kb = 0; kb < 2; ++kb)
#pragma unroll
            for (int sp = 0; sp < 2; ++sp) {
                const bf16x8 av0 = __builtin_shufflevector(vlo[kb][sp][0], vhi[kb][sp][0], 0, 1, 2, 3, 4, 5, 6, 7), av1 = __builtin_shufflevector(vlo[kb][sp][1], vhi[kb][sp][1], 0, 1, 2, 3, 4, 5, 6, 7);
                O0 = __builtin_amdgcn_mfma_f32_32x32x16_bf16(av0, bp[kb][sp], O0, 0, 0, 0);
                O1 = __builtin_amdgcn_mfma_f32_32x32x16_bf16(av1, bp[kb][sp], O1, 0, 0, 0);
            }
    };
    auto compute_pair = [&]() {
        const LAS unsigned char* kA = lds + q * KSTR + 16 * hh; const LAS unsigned char* kB = kA + KBUF;
        const LAS unsigned char* vA = lds + VS_OFF + q * VSTR + 8 * hh; const LAS unsigned char* vB = vA + VBUF;
        f32x16 a0, a1, b0, b1;
#pragma unroll
        for (int j = 0; j < 16; ++j) { a0[j] = 0.f; a1[j] = 0.f; b0[j] = 0.f; b1[j] = 0.f; }
#pragma unroll
        for (int hf = 0; hf < NKS / 2; ++hf) {
            bf16x8 ka0[2], ka1[2];
#pragma unroll
            for (int k2 = 0; k2 < 2; ++k2) { const int ks = hf * 2 + k2; ka0[k2] = *(const LAS bf16x8*)(kA + 32 * ks); ka1[k2] = *(const LAS bf16x8*)(kA + 32 * KSTR + 32 * ks); }
            __builtin_amdgcn_sched_barrier(0);
#pragma unroll
            for (int k2 = 0; k2 < 2; ++k2) { const int ks = hf * 2 + k2;
                a0 = __builtin_amdgcn_mfma_f32_32x32x16_bf16(ka0[k2], bq[ks], a0, 0, 0, 0);
                a1 = __builtin_amdgcn_mfma_f32_32x32x16_bf16(ka1[k2], bq[ks], a1, 0, 0, 0); }
            __builtin_amdgcn_sched_barrier(0);
        }
        float psA = 0.f;
        { bf16x8 kf0 = *(const LAS bf16x8*)(kB), kf1 = *(const LAS bf16x8*)(kB + 32 * KSTR);
#pragma unroll
          for (int ks = 0; ks < NKS; ++ks) {
              const bf16x8 c0 = kf0, c1 = kf1;
              if (ks + 1 < NKS) { kf0 = *(const LAS bf16x8*)(kB + 32 * (ks + 1)); kf1 = *(const LAS bf16x8*)(kB + 32 * KSTR + 32 * (ks + 1)); }
              b0 = __builtin_amdgcn_mfma_f32_32x32x16_bf16(c0, bq[ks], b0, 0, 0, 0);
              b1 = __builtin_amdgcn_mfma_f32_32x32x16_bf16(c1, bq[ks], b1, 0, 0, 0);
#pragma unroll
              for (int t = (ks * 32) / NKS; t < ((ks + 1) * 32) / NKS; ++t) { if (t < 16) { a0[t] = fast_exp2(a0[t]); psA += a0[t]; } else { a1[t - 16] = fast_exp2(a1[t - 16]); psA += a1[t - 16]; } }
              __builtin_amdgcn_sched_barrier(0);
          } }
        lsum += psA;
        bf16x8 bp[2][2];
#pragma unroll
        for (int sp = 0; sp < 2; ++sp) {
            u32x4 pw;
            pw.x = pk2(a0[8 * sp + 0], a0[8 * sp + 1]); pw.y = pk2(a0[8 * sp + 2], a0[8 * sp + 3]); pw.z = pk2(a0[8 * sp + 4], a0[8 * sp + 5]); pw.w = pk2(a0[8 * sp + 6], a0[8 * sp + 7]);
            bp[0][sp] = __builtin_bit_cast(bf16x8, pw);
            pw.x = pk2(a1[8 * sp + 0], a1[8 * sp + 1]); pw.y = pk2(a1[8 * sp + 2], a1[8 * sp + 3]); pw.z = pk2(a1[8 * sp + 4], a1[8 * sp + 5]); pw.w = pk2(a1[8 * sp + 6], a1[8 * sp + 7]);
            bp[1][sp] = __builtin_bit_cast(bf16x8, pw);
        }
        float psB = 0.f;
        { s16x4 l0 = *(const LAS s16x4*)(vA), h0 = *(const LAS s16x4*)(vA + 16), l1 = *(const LAS s16x4*)(vA + 32 * VSTR), h1 = *(const LAS s16x4*)(vA + 32 * VSTR + 16);
#pragma unroll
          for (int mi = 0; mi < 4; ++mi) {
              const bf16x8 av0 = __builtin_shufflevector(l0, h0, 0, 1, 2, 3, 4, 5, 6, 7), av1 = __builtin_shufflevector(l1, h1, 0, 1, 2, 3, 4, 5, 6, 7);
              if (mi + 1 < 4) { const int off = 32 * (mi + 1); l0 = *(const LAS s16x4*)(vA + off); h0 = *(const LAS s16x4*)(vA + off + 16); l1 = *(const LAS s16x4*)(vA + 32 * VSTR + off); h1 = *(const LAS s16x4*)(vA + 32 * VSTR + off + 16); }
              O0 = __builtin_amdgcn_mfma_f32_32x32x16_bf16(av0, bp[mi >> 1][mi & 1], O0, 0, 0, 0);
              O1 = __builtin_amdgcn_mfma_f32_32x32x16_bf16(av1, bp[mi >> 1][mi & 1], O1, 0, 0, 0);
#pragma unroll
              for (int t = 8 * mi; t < 8 * mi + 8; ++t) { if (t < 16) { b0[t] = fast_exp2(b0[t]); psB += b0[t]; } else { b1[t - 16] = fast_exp2(b1[t - 16]); psB += b1[t - 16]; } }
              __builtin_amdgcn_sched_barrier(0);
          } }
        lsum += psB;
#pragma unroll
        for (int sp = 0; sp < 2; ++sp) {
            u32x4 pw;
            pw.x = pk2(b0[8 * sp + 0], b0[8 * sp + 1]); pw.y = pk2(b0[8 * sp + 2], b0[8 * sp + 3]); pw.z = pk2(b0[8 * sp + 4], b0[8 * sp + 5]); pw.w = pk2(b0[8 * sp + 6], b0[8 * sp + 7]);
            bp[0][sp] = __builtin_bit_cast(bf16x8, pw);
            pw.x = pk2(b1[8 * sp + 0], b1[8 * sp + 1]); pw.y = pk2(b1[8 * sp + 2], b1[8 * sp + 3]); pw.z = pk2(b1[8 * sp + 4], b1[8 * sp + 5]); pw.w = pk2(b1[8 * sp + 6], b1[8 * sp + 7]);
            bp[1][sp] = __builtin_bit_cast(bf16x8, pw);
        }
        { s16x4 l0 = *(const LAS s16x4*)(vB), h0 = *(const LAS s16x4*)(vB + 16), l1 = *(const LAS s16x4*)(vB + 32 * VSTR), h1 = *(const LAS s16x4*)(vB + 32 * VSTR + 16);
#pragma unroll
          for (int mi = 0; mi < 4; ++mi) {
              const bf16x8 av0 = __builtin_shufflevector(l0, h0, 0, 1, 2, 3, 4, 5, 6, 7), av1 = __builtin_shufflevector(l1, h1, 0, 1, 2, 3, 4, 5, 6, 7);
              if (mi + 1 < 4) { const int off = 32 * (mi + 1); l0 = *(const LAS s16x4*)(vB + off); h0 = *(const LAS s16x4*)(vB + off + 16); l1 = *(const LAS s16x4*)(vB + 32 * VSTR + off); h1 = *(const LAS s16x4*)(vB + 32 * VSTR + off + 16); }
              O0 = __builtin_amdgcn_mfma_f32_32x32x16_bf16(av0, bp[mi >> 1][mi & 1], O0, 0, 0, 0);
              O1 = __builtin_amdgcn_mfma_f32_32x32x16_bf16(av1, bp[mi >> 1][mi & 1], O1, 0, 0, 0);
              __builtin_amdgcn_sched_barrier(0);
          } }
    };
    prefetch(0, pkA0, pkA1, pvA);
    if (ntiles > 1) prefetch(1, pkB0, pkB1, pvB);
    for (int i = 0; i < ntiles; i += 2) {
        const bool two = i + 1 < ntiles;
        __syncthreads();
        stage(0, pkA0, pkA1, pvA);
        if (two) stage(1, pkB0, pkB1, pvB);
        __syncthreads();
        if (i + 2 < ntiles) prefetch(i + 2, pkA0, pkA1, pvA);
        if (i + 3 < ntiles) prefetch(i + 3, pkB0, pkB1, pvB);
        if (MODE != 1 && two) compute_pair();
        else { compute(i, 0); if (two) compute(i + 1, 1); }
    }
    lsum += shx(lsum, 32, lane);
    const float inv = 1.f / lsum;
    bf16_t* op = (bf16_t*)(ows(P) + OFF_OX) + (size_t)(qrow0 + q) * DM + ocol + 4 * hh;
#pragma unroll
    for (int g4 = 0; g4 < 4; ++g4) {
        u32x2 w0, w1;
        w0.x = pk2(O0[4 * g4] * inv, O0[4 * g4 + 1] * inv); w0.y = pk2(O0[4 * g4 + 2] * inv, O0[4 * g4 + 3] * inv);
        w1.x = pk2(O1[4 * g4] * inv, O1[4 * g4 + 1] * inv); w1.y = pk2(O1[4 * g4 + 2] * inv, O1[4 * g4 + 3] * inv);
        *(u32x2*)(op + 8 * g4) = w0; *(u32x2*)(op + 32 + 8 * g4) = w1;
    }
    __syncthreads();
}
DI void phase_attn(const Params& P, int l, LAS unsigned char* lds, volatile LAS unsigned* itw, int slot) {
    unsigned* ctr = (unsigned*)(ows(P) + OFF_CTR) + 16 * slot;
    const int nit = 384 + 384 + (l == 0 ? 96 : 0);
    for (;;) {
        __syncthreads();
        if (threadIdx.x == 0) *itw = atomicAdd(ctr, 1u);
        __syncthreads();
        const int it = (int)*itw;
        if (it >= nit) break;
        if (it < 384) { const int qb = it & 7, h = (it >> 3) % 6, b = it / 48; attn_item<96, 0>(P, l, b, h, qb, lds); }
        else if (it < 768) { const int j = it - 384; const int qb = j & 7, h = (j >> 3) % 6, b = j / 48; attn_item<64, 1>(P, l, b, h, qb, lds); }
        else { const int j = it - 768; const int hd = j % 12, b = j / 12; if (hd < 6) attn_item<64, 2>(P, l, b, hd, 0, lds); else attn_item<96, 2>(P, l, b, hd - 6, 0, lds); }
    }
}

__global__ void __launch_bounds__(512, 2) fwd_megakernel(Params P) {
    extern __shared__ __attribute__((aligned(16))) unsigned char smem[];
    __shared__ __attribute__((aligned(16))) unsigned sh_words[4];
    LAS unsigned char* lds = (LAS unsigned char*)smem;
    if (threadIdx.x < 4) sh_words[threadIdx.x] = 0u;
    __syncthreads();
    XcdBarrier xb = xcd_barrier_post((unsigned*)(ows(P) + OFF_BAR), (volatile LAS unsigned*)sh_words);
    volatile LAS unsigned* itw = (volatile LAS unsigned*)sh_words + 2;

    phase_prep(P, lds);
    if (P.ws == nullptr) cg::this_grid().sync();
    xcd_barrier(xb);

    for (int l = 0; l < 2; ++l) {
        const float* ml = (const float*)(ows(P) + OFF_MODS) + (size_t)l * 9 * 9216;
        const float* sx = l == 0 ? P.in[oidx(0)] : P.out; float* sc = ((float*)(ows(P) + OFF_HXC));
        const int M2 = l == 0 ? TT : TX;
        phase_modulate(sx, sc, TT, P.in[oidx(6)] + (l * 3 + 0) * 1024, ml + 0 * 1024, ml + 1 * 1024, ((bf16_t*)(ows(P) + OFF_A)), l == 1 ? (const float*)(ows(P) + OFF_OX) : (const float*)nullptr);
        xcd_barrier(xb);
        { pg8::EpiSwiglu e; e.H = ((bf16_t*)(ows(P) + OFF_H)); e.ldh = DFF; gemm_call(lds, ((bf16_t*)(ows(P) + OFF_A)), DM, (const bf16_t*)(ows(P) + OFF_WGU) + (size_t)(l * 2 + 0) * 5632 * 1024, 1024, TT, 5632, 1024, e, 0); }
        deferred_transposes(P, lds, l == 0 ? 0 : 99, 48);
        xcd_barrier(xb);
        { pg8::EpiResid e; e.rin_x = sx; e.rin_c = sc; e.rout_x = P.out; e.rout_c = ((float*)(ows(P) + OFF_HXC)); e.gate = ml + 2 * 1024; e.gs = 0.5f;
          gemm_call(lds, ((bf16_t*)(ows(P) + OFF_H)), DFF, (const bf16_t*)(ows(P) + OFF_WDN) + (size_t)(l * 2 + 0) * 1024 * 2816, 2816, TX, 1024, 2816, e, 0); }
        for (int kq = 0; kq < 4; ++kq) {
          const int koff = kq < 2 ? 768 * kq : 1536 + 640 * (kq - 2), klen = kq < 2 ? 768 : 640;
          pg8::EpiResidAtomicC e; e.rout_c = ((float*)(ows(P) + OFF_OX)) + (size_t)kq * TC * DM; e.gate = ml + 2 * 1024; e.gs = 0.5f;
          gemm_call(lds, ((bf16_t*)(ows(P) + OFF_H)) + (size_t)TX * DFF + koff, DFF, (const bf16_t*)(ows(P) + OFF_WDN) + (size_t)(l * 2 + 0) * 1024 * 2816 + koff, 2816, TC, 1024, klen, e, 256 - 32 * kq); }
        deferred_transposes(P, lds, l == 0 ? 1 : 99, 128);
        xcd_barrier(xb);
        phase_modulate(P.out, ((float*)(ows(P) + OFF_HXC)), TT, P.in[oidx(6)] + (l * 3 + 1) * 1024, ml + 3 * 1024, ml + 4 * 1024, ((bf16_t*)(ows(P) + OFF_A)), (const float*)(ows(P) + OFF_OX));
        xcd_barrier(xb);
        { pg8::EpiStore e; e.O = ((bf16_t*)(ows(P) + OFF_Z)); e.ldo = NZ; e.rows_valid = TT; e.cols_valid = NZ; e.kmap = 0;
          gemm_call(lds, ((bf16_t*)(ows(P) + OFF_A)), DM, (const bf16_t*)(ows(P) + OFF_WIN) + (size_t)l * NZ * 1024, 1024, TT, NZ, 1024, e, 0); }
        xcd_barrier(xb);
        phase_znorm(P, l);
        phase_s5_s1(P, l);
        xcd_barrier(xb);
        phase_s5_s2(P, l, lds);
        { pg8::EpiStore e; e.O = (bf16_t*)(ows(P) + OFF_QM); e.ldo = 576; e.rows_valid = TT; e.cols_valid = 576; e.kmap = 0;
          gemm_call(lds, ((bf16_t*)(ows(P) + OFF_Z)) + ZCQ, NZ, (const bf16_t*)(ows(P) + OFF_WUQ) + (size_t)l * 768 * 384, 384, l == 0 ? TT : TX, 768, 384, e, 0); }
        { pg8::EpiStore e; e.O = (bf16_t*)(ows(P) + OFF_KM); e.ldo = 576; e.rows_valid = TT; e.cols_valid = 384; e.kmap = 1;
          gemm_call(lds, ((bf16_t*)(ows(P) + OFF_Z)) + ZCKV, NZ, (const bf16_t*)(ows(P) + OFF_WUK) + (size_t)l * 512 * 256, 256, TT, 512, 256, e, 40); }
        { pg8::EpiStore e; e.O = (bf16_t*)(ows(P) + OFF_VTM); e.ldo = TT; e.rows_valid = 384; e.cols_valid = TT; e.kmap = 0;
          gemm_call(lds, (const bf16_t*)(ows(P) + OFF_WUV) + (size_t)l * 512 * 256, 256, ((bf16_t*)(ows(P) + OFF_Z)) + ZCKV, NZ, 512, TT, 256, e, 152); }
        { pg8::EpiStore e; e.O = (bf16_t*)(ows(P) + OFF_VTA); e.ldo = TT; e.rows_valid = 384; e.cols_valid = TT; e.kmap = 0;
          gemm_call(lds, (const bf16_t*)(ows(P) + OFF_WVA) + (size_t)l * 512 * 1024, 1024, ((bf16_t*)(ows(P) + OFF_A)), DM, 512, TT, 1024, e, 8); }
        xcd_barrier(xb);
        phase_finish(P, l);
        phase_s5_s3(P, l);
        xcd_barrier(xb);
        { pg8::EpiGlu e; e.O = ((bf16_t*)(ows(P) + OFF_OX)); e.ldo = DM; e.col_base = 768; e.bias = P.in[oidx(27)] + l * 512;
          gemm_call(lds, (const bf16_t*)(ows(P) + OFF_YB), 256, (const bf16_t*)(ows(P) + OFF_WGLU) + (size_t)l * 512 * 256, 256, M2, 512, 256, e, 0); }
        phase_attn(P, l, lds, itw, l * 2 + 1);
        xcd_barrier(xb);
        { pg8::EpiResid e; e.rin_x = P.out; e.rin_c = ((float*)(ows(P) + OFF_HXC)); e.rout_x = P.out; e.rout_c = ((float*)(ows(P) + OFF_HXC)); e.gate = ml + 5 * 1024; e.gs = 1.0f;
          gemm_call(lds, ((bf16_t*)(ows(P) + OFF_OX)), DM, (const bf16_t*)(ows(P) + OFF_WOUT) + (size_t)l * 1024 * 1024, 1024, TX, 1024, 1024, e, 0); }
        if (l == 0) for (int kq = 0; kq < 4; ++kq) {
          pg8::EpiResidAtomicC e; e.rout_c = ((float*)(ows(P) + OFF_Z)) + (size_t)kq * TC * DM; e.gate = ml + 5 * 1024; e.gs = 1.0f;
          gemm_call(lds, ((bf16_t*)(ows(P) + OFF_OX)) + (size_t)TX * DM + kq * 256, DM, (const bf16_t*)(ows(P) + OFF_WOUT) + (size_t)l * 1024 * 1024 + kq * 256, 1024, TC, 1024, 256, e, 256 - 32 * kq); }
        xcd_barrier(xb);
        phase_modulate(P.out, ((float*)(ows(P) + OFF_HXC)), M2, P.in[oidx(6)] + (l * 3 + 2) * 1024, ml + 6 * 1024, ml + 7 * 1024, ((bf16_t*)(ows(P) + OFF_A)), l == 0 ? (const float*)(ows(P) + OFF_Z) : (const float*)nullptr);
        xcd_barrier(xb);
        { pg8::EpiSwiglu e; e.H = ((bf16_t*)(ows(P) + OFF_H)); e.ldh = DFF; gemm_call(lds, ((bf16_t*)(ows(P) + OFF_A)), DM, (const bf16_t*)(ows(P) + OFF_WGU) + (size_t)(l * 2 + 1) * 5632 * 1024, 1024, M2, 5632, 1024, e, 0); }
        deferred_transposes(P, lds, l == 0 ? 2 : 99, 48);
        xcd_barrier(xb);
        { pg8::EpiResid e; e.rin_x = P.out; e.rin_c = ((float*)(ows(P) + OFF_HXC)); e.rout_x = P.out; e.rout_c = ((float*)(ows(P) + OFF_HXC)); e.gate = ml + 8 * 1024; e.gs = 0.5f;
          gemm_call(lds, ((bf16_t*)(ows(P) + OFF_H)), DFF, (const bf16_t*)(ows(P) + OFF_WDN) + (size_t)(l * 2 + 1) * 1024 * 2816, 2816, TX, 1024, 2816, e, 0); }
        if (l == 0) for (int kq = 0; kq < 4; ++kq) {
          const int koff = kq < 2 ? 768 * kq : 1536 + 640 * (kq - 2), klen = kq < 2 ? 768 : 640;
          pg8::EpiResidAtomicC e; e.rout_c = ((float*)(ows(P) + OFF_OX)) + (size_t)kq * TC * DM; e.gate = ml + 8 * 1024; e.gs = 0.5f;
          gemm_call(lds, ((bf16_t*)(ows(P) + OFF_H)) + (size_t)TX * DFF + koff, DFF, (const bf16_t*)(ows(P) + OFF_WDN) + (size_t)(l * 2 + 1) * 1024 * 2816 + koff, 2816, TC, 1024, klen, e, 256 - 32 * kq); }
        deferred_transposes(P, lds, l == 0 ? 3 : 99, 128);
        if (l == 0) xcd_barrier(xb);
    }
}

constexpr int LDS_BYTES = 131072;
extern "C" void kernel_launch(void* const* d_in, const int* in_sizes, int n_in, void* d_out, int out_size, void* d_ws, size_t ws_size, hipStream_t stream) {
    static int grid = 0;
    if (grid == 0) {
        if (n_in != 28 || ws_size < WS_END) { fprintf(stderr, "kernel_launch: unexpected inputs (n_in %d, ws %zu < %zu)\n", n_in, ws_size, (size_t)WS_END); grid = -1; return; }
        int dev = 0, cus = 0, per_cu = 0;
        hipGetDevice(&dev); hipDeviceGetAttribute(&cus, hipDeviceAttributeMultiprocessorCount, dev);
        if (hipFuncSetAttribute((const void*)fwd_megakernel, hipFuncAttributeMaxDynamicSharedMemorySize, LDS_BYTES) != hipSuccess) { fprintf(stderr, "kernel_launch: hipFuncSetAttribute failed\n"); grid = -1; return; }
        hipOccupancyMaxActiveBlocksPerMultiprocessor(&per_cu, (const void*)fwd_megakernel, 512, LDS_BYTES);
        if (per_cu < 1) { fprintf(stderr, "kernel_launch: occupancy query says %d\n", per_cu); per_cu = 1; }
        (void)hipGetLastError();
        if (cus != 256) { fprintf(stderr, "kernel_launch: built for a 256-CU device (got %d); nothing launched\n", cus); grid = -1; return; }
        grid = cus;
    }
    if (grid < 0) return;
    hipMemsetAsync((char*)d_ws + OFF_BAR, 0, 20480, stream);
    Params p{};
    for (int i = 0; i < 28; ++i) p.in[i] = (const float*)d_in[i];
    p.out = (float*)d_out; p.ws = (unsigned char*)d_ws;
    void* args[] = {&p};
    hipError_t e = hipLaunchCooperativeKernel((const void*)fwd_megakernel, dim3(grid), dim3(512), args, LDS_BYTES, stream);
    if (e != hipSuccess) fprintf(stderr, "cooperative launch failed: %s (grid %d)\n", hipGetErrorString(e), grid);
}
```
